# Optimizing an MI355X kernel written in HIP

```python
import jax, jax.numpy as jnp
from jax import lax
import numpy as np

D_MODEL = 1024
BATCH = 8
SEQ = 2048
DEPTH = 2

GRID_W = 64
CTX_LEN = 256
HEAD_DIM = 64
Q_BLOCK = 128
ROPE_THETA = 10000.0
EPS = 1e-6
NEG = -1e30

A_HEADS = 4
A_KV_HEADS = 2
B_HEADS = 4
B_NOPE = 64
B_ROPE = 32
B_V = 64
B_KV_RANK = 128
C_HEADS = 4
C_KV_HEADS = 2
C_WINDOW = 128
D_HEADS = 4
NA_ROWS = 8
NA_COLS = 16
NA_QCOLS = 16
NA_KCOLS = NA_QCOLS + NA_COLS

N_EXPERTS = 64
TOP_K = 8
N_GROUPS = 8
TOPK_GROUPS = 4
EXPERT_DIM = 256
SHARED_DIM = 256
ROUTED_SCALE = 2.5
MOE_BLOCK = 128

A_Q = A_HEADS * HEAD_DIM
A_KV = A_KV_HEADS * HEAD_DIM
B_Q = B_HEADS * (B_NOPE + B_ROPE)
C_Q = C_HEADS * HEAD_DIM
C_KV = C_KV_HEADS * HEAD_DIM
D_QKV = D_HEADS * HEAD_DIM
IN_SPLITS = (A_Q, A_KV, A_KV, B_Q, B_KV_RANK, B_ROPE, C_Q, C_KV, C_KV, D_QKV, D_QKV, D_QKV)
IN_WIDTH = A_Q + 2 * A_KV + B_Q + B_KV_RANK + B_ROPE + C_Q + 2 * C_KV + 3 * D_QKV
MIX_WIDTH = A_HEADS * HEAD_DIM + B_HEADS * B_V + C_HEADS * HEAD_DIM + D_HEADS * HEAD_DIM

kernel_name = "hybrid_parallel_heads_moe_dit_block"


def _rms_norm(x, g):
    xf = x.astype(jnp.float32)
    y = xf * lax.rsqrt(jnp.mean(xf * xf, axis=-1, keepdims=True) + EPS)
    return (y * g.astype(jnp.float32)).astype(x.dtype)


def _axial_rope(n_tok, dim):
    t = jnp.arange(n_tok)
    row = (t // GRID_W).astype(jnp.float32)
    col = (t % GRID_W).astype(jnp.float32)
    quarter = dim // 4
    freqs = ROPE_THETA ** (-jnp.arange(quarter, dtype=jnp.float32) / quarter)
    ar = row[:, None] * freqs
    ac = col[:, None] * freqs
    ang = jnp.concatenate([ar, ar, ac, ac], axis=-1)
    return jnp.cos(ang), jnp.sin(ang)


def _rope(x, cos, sin):
    xf = x.astype(jnp.float32)
    x1, x2, x3, x4 = jnp.split(xf, 4, axis=-1)
    rot = jnp.concatenate([-x2, x1, -x4, x3], axis=-1)
    return (xf * cos + rot * sin).astype(x.dtype)


def _heads(x, n):
    b, t, _ = x.shape
    return x.reshape(b, t, n, -1).transpose(0, 2, 1, 3)


def _merge(x):
    b, h, t, d = x.shape
    return x.transpose(0, 2, 1, 3).reshape(b, t, h * d)


def _group(x, hk):
    b, h, t, d = x.shape
    return x.reshape(b, hk, h // hk, t, d)


def _ungroup(x):
    b, hk, g, t, d = x.shape
    return x.reshape(b, hk * g, t, d)


def _split_cols(p):
    offs, acc = [], 0
    for w in IN_SPLITS[:-1]:
        acc += w
        offs.append(acc)
    return jnp.split(p, offs, axis=-1)


def _dense_block_attn(q, k, v, scale):
    bsz, hk, g, sq, dk = q.shape
    nb = sq // Q_BLOCK
    qb = jnp.moveaxis(q.reshape(bsz, hk, g, nb, Q_BLOCK, dk), 3, 0)

    def one_block(qi):
        s = jnp.einsum("bhgqd,bhkd->bhgqk", qi, k, preferred_element_type=jnp.float32) * scale
        p = jax.nn.softmax(s, axis=-1).astype(v.dtype)
        return jnp.einsum("bhgqk,bhkd->bhgqd", p, v)

    o = lax.map(one_block, qb)
    return jnp.moveaxis(o, 0, 3).reshape(bsz, hk, g, sq, v.shape[-1])


def _ctx_attn(q, k, v, scale, sink=None):
    s = jnp.einsum("bhgqd,bhkd->bhgqk", q, k, preferred_element_type=jnp.float32) * scale
    if sink is not None:
        s_sink = jnp.broadcast_to(sink.astype(jnp.float32)[None, :, :, None, None], s.shape[:-1] + (1,))
        s = jnp.concatenate([s, s_sink], axis=-1)
    p = jax.nn.softmax(s, axis=-1)[..., :k.shape[2]].astype(v.dtype)
    return jnp.einsum("bhgqk,bhkd->bhgqd", p, v)


def _window_attn(q, k, v, kc, vc, sink, scale):
    bsz, hk, g, s_len, d = q.shape
    halo = -(-C_WINDOW // Q_BLOCK)
    nb = s_len // Q_BLOCK
    nkb = (2 * halo + 1) * Q_BLOCK
    pad = ((0, 0), (0, 0), (halo * Q_BLOCK, halo * Q_BLOCK), (0, 0))

    def band(t):
        tp = jnp.pad(t, pad).reshape(bsz, hk, nb + 2 * halo, Q_BLOCK, t.shape[-1])
        return jnp.concatenate([tp[:, :, j:j + nb] for j in range(2 * halo + 1)], axis=3)

    kb, vb = band(k), band(v)
    qb = q.reshape(bsz, hk, g, nb, Q_BLOCK, d)
    s_band = jnp.einsum("bhgnqd,bhnkd->bhgnqk", qb, kb, preferred_element_type=jnp.float32) * scale
    qpos = (jnp.arange(nb)[:, None] * Q_BLOCK + jnp.arange(Q_BLOCK))[:, :, None]
    kpos = (jnp.arange(nb)[:, None] * Q_BLOCK - halo * Q_BLOCK + jnp.arange(nkb))[:, None, :]
    valid = (kpos >= 0) & (kpos < s_len) & (jnp.abs(qpos - kpos) <= C_WINDOW)
    s_band = jnp.where(valid, s_band, NEG)
    s_ctx = jnp.einsum("bhgnqd,bhld->bhgnql", qb, kc, preferred_element_type=jnp.float32) * scale
    s_sink = jnp.broadcast_to(sink.astype(jnp.float32)[None, :, :, None, None, None], s_band.shape[:-1] + (1,))
    p = jax.nn.softmax(jnp.concatenate([s_band, s_ctx, s_sink], axis=-1), axis=-1)
    n_ctx = kc.shape[2]
    o = (jnp.einsum("bhgnqk,bhnkd->bhgnqd", p[..., :nkb].astype(v.dtype), vb)
         + jnp.einsum("bhgnql,bhld->bhgnqd", p[..., nkb:nkb + n_ctx].astype(vc.dtype), vc))
    return o.reshape(bsz, hk, g, s_len, d)


def _neighbourhood_attn(q, k, v, kc, vc, rpb, scale):
    bsz, nh, s_len, d = q.shape
    rows = s_len // GRID_W
    wr = min(NA_ROWS, rows)
    ncb = GRID_W // NA_QCOLS
    r = jnp.arange(rows)
    rs = jnp.clip(r - wr // 2, 0, rows - wr)
    key_rows = rs[:, None] + jnp.arange(wr)
    cb = jnp.arange(ncb)
    c0 = jnp.clip(cb * NA_QCOLS - NA_COLS // 2, 0, GRID_W - NA_KCOLS)
    key_cols = c0[:, None] + jnp.arange(NA_KCOLS)
    nk = wr * NA_KCOLS
    key_idx = (key_rows[:, None, :, None] * GRID_W + key_cols[None, :, None, :]).reshape(rows, ncb, nk)
    kg = jnp.take(k, key_idx, axis=2)
    vg = jnp.take(v, key_idx, axis=2)
    qb = q.reshape(bsz, nh, rows, ncb, NA_QCOLS, d)
    s_nb = jnp.einsum("bhrcqd,bhrckd->bhrcqk", qb, kg, preferred_element_type=jnp.float32) * scale
    q_cols = cb[:, None] * NA_QCOLS + jnp.arange(NA_QCOLS)
    q_cs = jnp.clip(q_cols - NA_COLS // 2, 0, GRID_W - NA_COLS)
    kcol = key_cols[:, None, :]
    col_ok = (kcol >= q_cs[:, :, None]) & (kcol < q_cs[:, :, None] + NA_COLS)
    mask = jnp.broadcast_to(col_ok[:, :, None, :], (ncb, NA_QCOLS, wr, NA_KCOLS)).reshape(ncb, NA_QCOLS, nk)
    dr = key_rows - r[:, None] + NA_ROWS - 1
    dc = jnp.clip(kcol - q_cols[:, :, None] + NA_COLS - 1, 0, 2 * NA_COLS - 2)
    bias = rpb[:, dr[:, None, None, :, None], dc[None, :, :, None, :]]
    bias = bias.reshape(nh, rows, ncb, NA_QCOLS, nk).astype(jnp.float32)
    s_nb = jnp.where(mask, s_nb + bias, NEG)
    s_ctx = jnp.einsum("bhrcqd,bhld->bhrcql", qb, kc, preferred_element_type=jnp.float32) * scale
    p = jax.nn.softmax(jnp.concatenate([s_nb, s_ctx], axis=-1), axis=-1)
    o = (jnp.einsum("bhrcqk,bhrckd->bhrcqd", p[..., :nk].astype(v.dtype), vg)
         + jnp.einsum("bhrcql,bhld->bhrcqd", p[..., nk:].astype(vc.dtype), vc))
    return o.reshape(bsz, nh, s_len, d)


def _mixer_full_gqa(q, k, v, qc, kc, vc, q_gain, k_gain, cos, sin, with_ctx):
    scale = HEAD_DIM ** -0.5
    bsz, s_len, _ = q.shape
    ql = _rope(_rms_norm(_heads(q, A_HEADS), q_gain), cos, sin)
    kl = _rope(_rms_norm(_heads(k, A_KV_HEADS), k_gain), cos, sin)
    kcx = _rms_norm(_heads(kc, A_KV_HEADS), k_gain)
    vl, vcx = _heads(v, A_KV_HEADS), _heads(vc, A_KV_HEADS)
    o = _dense_block_attn(_group(ql, A_KV_HEADS), jnp.concatenate([kl, kcx], axis=2),
                          jnp.concatenate([vl, vcx], axis=2), scale)
    out = _merge(_ungroup(o))
    out_c = None
    if with_ctx:
        qcx = _rms_norm(_heads(qc, A_HEADS), q_gain)
        out_c = _merge(_ungroup(_ctx_attn(_group(qcx, A_KV_HEADS), kcx, vcx, scale)))
    return out, out_c


def _mixer_mla(q, ckv, kr, qc, ckvc, krc, kv_gain, w_kv_up, cos, sin, with_ctx):
    scale = (B_NOPE + B_ROPE) ** -0.5

    def expand(c_lat, k_rope):
        kv = _heads(_rms_norm(c_lat, kv_gain) @ w_kv_up, B_HEADS)
        kr_h = jnp.broadcast_to(k_rope[:, None], kv.shape[:-1] + (B_ROPE,))
        return jnp.concatenate([kv[..., :B_NOPE], kr_h], axis=-1), kv[..., B_NOPE:]

    kl, vl = expand(ckv, _rope(kr, cos, sin))
    kcx, vcx = expand(ckvc, krc)
    qh = _heads(q, B_HEADS)
    ql = jnp.concatenate([qh[..., :B_NOPE], _rope(qh[..., B_NOPE:], cos, sin)], axis=-1)
    o = _dense_block_attn(ql[:, :, None], jnp.concatenate([kl, kcx], axis=2),
                          jnp.concatenate([vl, vcx], axis=2), scale)
    out = _merge(o[:, :, 0])
    out_c = None
    if with_ctx:
        out_c = _merge(_ctx_attn(_heads(qc, B_HEADS)[:, :, None], kcx, vcx, scale)[:, :, 0])
    return out, out_c


def _mixer_window_gqa(q, k, v, qc, kc, vc, sink, cos, sin, with_ctx):
    scale = HEAD_DIM ** -0.5
    sink_g = sink.reshape(C_KV_HEADS, C_HEADS // C_KV_HEADS)
    ql = _rope(_heads(q, C_HEADS), cos, sin)
    kl = _rope(_heads(k, C_KV_HEADS), cos, sin)
    vl = _heads(v, C_KV_HEADS)
    kcx, vcx = _heads(kc, C_KV_HEADS), _heads(vc, C_KV_HEADS)
    out = _merge(_ungroup(_window_attn(_group(ql, C_KV_HEADS), kl, vl, kcx, vcx, sink_g, scale)))
    out_c = None
    if with_ctx:
        qcx = _group(_heads(qc, C_HEADS), C_KV_HEADS)
        out_c = _merge(_ungroup(_ctx_attn(qcx, kcx, vcx, scale, sink_g)))
    return out, out_c


def _mixer_neighbourhood(q, k, v, qc, kc, vc, rpb, with_ctx):
    scale = HEAD_DIM ** -0.5
    kcx, vcx = _heads(kc, D_HEADS), _heads(vc, D_HEADS)
    out = _merge(_neighbourhood_attn(_heads(q, D_HEADS), _heads(k, D_HEADS), _heads(v, D_HEADS),
                                     kcx, vcx, rpb, scale))
    out_c = None
    if with_ctx:
        out_c = _merge(_ctx_attn(_heads(qc, D_HEADS)[:, :, None], kcx, vcx, scale)[:, :, 0])
    return out, out_c


def _route(h, w_r, b_r):
    s = jax.nn.sigmoid(jnp.matmul(h, w_r, preferred_element_type=jnp.float32))
    sb = s + b_r.astype(jnp.float32)
    n_tok = s.shape[0]
    per = N_EXPERTS // N_GROUPS
    gscore = lax.top_k(sb.reshape(n_tok, N_GROUPS, per), 2)[0].sum(-1)
    _, gidx = lax.top_k(gscore, TOPK_GROUPS)
    gmask = jnp.sum(jax.nn.one_hot(gidx, N_GROUPS, dtype=jnp.float32), axis=1)
    emask = jnp.repeat(gmask, per, axis=1) > 0
    _, idx = lax.top_k(jnp.where(emask, sb, -jnp.inf), TOP_K)
    w = jnp.take_along_axis(s, idx, axis=1)
    w = w / jnp.sum(w, axis=-1, keepdims=True) * ROUTED_SCALE
    return idx, w


def _swiglu(x, wg, wu, wd):
    return (jax.nn.silu(x @ wg) * (x @ wu)) @ wd


def _moe_routed(h, idx, wts, wg, wu, wd):
    n_tok, dm = h.shape
    n_asg = n_tok * TOP_K
    flat_e = idx.reshape(-1)
    order = jnp.argsort(flat_e)
    sorted_e = flat_e[order]
    counts = jnp.bincount(flat_e, length=N_EXPERTS)
    padded = (counts + MOE_BLOCK - 1) // MOE_BLOCK * MOE_BLOCK
    pad_end = jnp.cumsum(padded)
    pad_start = pad_end - padded
    raw_start = jnp.cumsum(counts) - counts
    slot = pad_start[sorted_e] + jnp.arange(n_asg) - raw_start[sorted_e]
    n_blocks = -(-(n_asg + N_EXPERTS * (MOE_BLOCK - 1)) // MOE_BLOCK)
    n_slots = n_blocks * MOE_BLOCK
    slot_tok = jnp.full((n_slots,), n_tok, jnp.int32).at[slot].set((order // TOP_K).astype(jnp.int32))
    slot_w = jnp.zeros((n_slots,), wts.dtype).at[slot].set(wts.reshape(-1)[order])
    block_e = jnp.minimum(jnp.searchsorted(pad_end, jnp.arange(n_blocks) * MOE_BLOCK, side="right"),
                          N_EXPERTS - 1)
    h_pad = jnp.concatenate([h, jnp.zeros((1, dm), h.dtype)], axis=0)

    def step(acc, blk):
        tok, w, e = blk
        xb = h_pad[tok]
        y = (jax.nn.silu(xb @ wg[e]) * (xb @ wu[e])) @ wd[e]
        return acc.at[tok].add(y * w[:, None].astype(y.dtype)), None

    acc, _ = lax.scan(step, jnp.zeros((n_tok + 1, dm), h.dtype),
                      (slot_tok.reshape(n_blocks, MOE_BLOCK), slot_w.reshape(n_blocks, MOE_BLOCK), block_e))
    return acc[:n_tok]


def _moe(h, w_r, b_r, wg, wu, wd, swg, swu, swd):
    idx, wts = _route(h, w_r, b_r)
    return _moe_routed(h, idx, wts, wg, wu, wd) + _swiglu(h, swg, swu, swd)


def setup_inputs(seed: int = 0) -> dict:
    key = jax.random.key(seed)
    ks = jax.random.split(key, 32)
    f32 = jnp.float32
    L = DEPTH

    def nrm(k, shape, scale):
        return jax.random.normal(k, shape, f32) * scale

    return {
        "x": nrm(ks[0], (BATCH, SEQ, D_MODEL), 1.0),
        "c": nrm(ks[1], (BATCH, D_MODEL), 1.0),
        "ctx": nrm(ks[2], (BATCH, CTX_LEN, D_MODEL), 1.0),
        "c_ctx": nrm(ks[3], (D_MODEL,), 1.0),
        "ada_w": nrm(ks[4], (L, D_MODEL, 6 * D_MODEL), 0.5 * D_MODEL ** -0.5),
        "ada_b": nrm(ks[5], (L, 6 * D_MODEL), 0.01),
        "pre_mix_g": 1.0 + nrm(ks[6], (L, D_MODEL), 0.1),
        "post_mix_g": 1.0 + nrm(ks[7], (L, D_MODEL), 0.1),
        "pre_ffn_g": 1.0 + nrm(ks[8], (L, D_MODEL), 0.1),
        "post_ffn_g": 1.0 + nrm(ks[9], (L, D_MODEL), 0.1),
        "w_in": nrm(ks[10], (L, D_MODEL, IN_WIDTH), D_MODEL ** -0.5),
        "a_q_norm": 1.0 + nrm(ks[11], (L, HEAD_DIM), 0.1),
        "a_k_norm": 1.0 + nrm(ks[12], (L, HEAD_DIM), 0.1),
        "b_kv_norm": 1.0 + nrm(ks[13], (L, B_KV_RANK), 0.1),
        "b_w_kv_up": nrm(ks[14], (L, B_KV_RANK, B_HEADS * (B_NOPE + B_V)), B_KV_RANK ** -0.5),
        "c_sink": nrm(ks[15], (L, C_HEADS), 1.0),
        "d_rpb": nrm(ks[16], (L, D_HEADS, 2 * NA_ROWS - 1, 2 * NA_COLS - 1), 0.2),
        "w_out": nrm(ks[17], (L, MIX_WIDTH, D_MODEL), MIX_WIDTH ** -0.5),
        "router_w": nrm(ks[18], (L, D_MODEL, N_EXPERTS), D_MODEL ** -0.5),
        "router_b": nrm(ks[19], (L, N_EXPERTS), 0.01),
        "exp_w_gate": nrm(ks[20], (L, N_EXPERTS, D_MODEL, EXPERT_DIM), D_MODEL ** -0.5),
        "exp_w_up": nrm(ks[21], (L, N_EXPERTS, D_MODEL, EXPERT_DIM), D_MODEL ** -0.5),
        "exp_w_down": nrm(ks[22], (L, N_EXPERTS, EXPERT_DIM, D_MODEL), EXPERT_DIM ** -0.5),
        "sh_w_gate": nrm(ks[23], (L, D_MODEL, SHARED_DIM), D_MODEL ** -0.5),
        "sh_w_up": nrm(ks[24], (L, D_MODEL, SHARED_DIM), D_MODEL ** -0.5),
        "sh_w_down": nrm(ks[25], (L, SHARED_DIM, D_MODEL), SHARED_DIM ** -0.5),
    }


def reference(x, c, ctx, c_ctx, ada_w, ada_b, pre_mix_g, post_mix_g, pre_ffn_g, post_ffn_g,
              w_in, a_q_norm, a_k_norm, b_kv_norm, b_w_kv_up, c_sink, d_rpb, w_out,
              router_w, router_b, exp_w_gate, exp_w_up, exp_w_down, sh_w_gate, sh_w_up, sh_w_down):
    bsz, s_len, dm = x.shape
    cos_h, sin_h = _axial_rope(s_len, HEAD_DIM)
    cos_r, sin_r = _axial_rope(s_len, B_ROPE)
    xc = ctx
    c_act = jax.nn.silu(c)
    cc_act = jax.nn.silu(c_ctx)
    for l in range(DEPTH):
        with_ctx = l < DEPTH - 1
        mod = (c_act @ ada_w[l] + ada_b[l])[:, None, :]
        modc = cc_act @ ada_w[l] + ada_b[l]
        sh1, sc1, g1, sh2, sc2, g2 = jnp.split(mod, 6, axis=-1)
        sh1c, sc1c, g1c, sh2c, sc2c, g2c = jnp.split(modc, 6, axis=-1)

        h = _rms_norm(x, pre_mix_g[l]) * (1.0 + sc1) + sh1
        hc = _rms_norm(xc, pre_mix_g[l]) * (1.0 + sc1c) + sh1c
        p = _split_cols(h @ w_in[l])
        pc = _split_cols(hc @ w_in[l])
        oa, oa_c = _mixer_full_gqa(p[0], p[1], p[2], pc[0], pc[1], pc[2], a_q_norm[l], a_k_norm[l],
                                   cos_h, sin_h, with_ctx)
        ob, ob_c = _mixer_mla(p[3], p[4], p[5], pc[3], pc[4], pc[5], b_kv_norm[l], b_w_kv_up[l],
                              cos_r, sin_r, with_ctx)
        ow, ow_c = _mixer_window_gqa(p[6], p[7], p[8], pc[6], pc[7], pc[8], c_sink[l], cos_h, sin_h, with_ctx)
        on, on_c = _mixer_neighbourhood(p[9], p[10], p[11], pc[9], pc[10], pc[11], d_rpb[l], with_ctx)
        mix = jnp.concatenate([oa, ob, ow, on], axis=-1) @ w_out[l]
        x = x + g1 * _rms_norm(mix, post_mix_g[l])
        if with_ctx:
            mixc = jnp.concatenate([oa_c, ob_c, ow_c, on_c], axis=-1) @ w_out[l]
            xc = xc + g1c * _rms_norm(mixc, post_mix_g[l])

        h2 = (_rms_norm(x, pre_ffn_g[l]) * (1.0 + sc2) + sh2).reshape(-1, dm)
        if with_ctx:
            h2c = (_rms_norm(xc, pre_ffn_g[l]) * (1.0 + sc2c) + sh2c).reshape(-1, dm)
            tokens = jnp.concatenate([h2, h2c], axis=0)
        else:
            tokens = h2
        f = _moe(tokens, router_w[l], router_b[l], exp_w_gate[l], exp_w_up[l], exp_w_down[l],
                 sh_w_gate[l], sh_w_up[l], sh_w_down[l])
        n_lat = bsz * s_len
        x = x + g2 * _rms_norm(f[:n_lat].reshape(bsz, s_len, dm), post_ffn_g[l])
        if with_ctx:
            xc = xc + g2c * _rms_norm(f[n_lat:].reshape(bsz, -1, dm), post_ffn_g[l])
    return x
```

```cpp
#include <hip/hip_runtime.h>
#include <stdint.h>
#include <stdio.h>
#include <string.h>

#ifndef ONE_LAUNCH
#define ONE_LAUNCH 1
#endif

#define DEVI __device__ __forceinline__
#define LAS __attribute__((address_space(3)))

typedef unsigned short bf16_t;
typedef short bf16x8 __attribute__((ext_vector_type(8)));
typedef short s16x4 __attribute__((ext_vector_type(4)));
typedef float f32x4 __attribute__((ext_vector_type(4)));
typedef float f32x2 __attribute__((ext_vector_type(2)));
typedef __bf16 bf16x2_t __attribute__((ext_vector_type(2)));
typedef unsigned u32x4 __attribute__((ext_vector_type(4)));
typedef unsigned u32x2 __attribute__((ext_vector_type(2)));
typedef LAS char lchar;

constexpr int DM = 1024, BATCH = 8, SEQ = 2048, CTXL = 256, DEPTH = 2;
constexpr int T_LAT = BATCH * SEQ, T_CTX = BATCH * CTXL, T_ALL = T_LAT + T_CTX;
constexpr int IN_W = 2336, NP = 2432, NKV = 512;
constexpr int NEXP = 64, EDIM = 256;
constexpr float EPS = 1e-6f;
constexpr float LOG2E = 1.4426950408889634f;
constexpr int PC_AQ = 0, PC_AK = 256, PC_AV = 384, PC_BQN = 512, PC_BQR = 768, PC_CKV = 896, PC_CQ = 1024, PC_CK = 1280, PC_CV = 1408,
              PC_DQ = 1536, PC_DK = 1792, PC_DV = 2048, PC_BKR = 2304;
constexpr int RSLOTS = 147456 + 64 * 128;
constexpr int SH_BASE = RSLOTS;
constexpr int ACT_ROWS = RSLOTS + T_ALL;
constexpr int RT_TILE = 16;
constexpr int MAX_RT = T_ALL / RT_TILE;

constexpr size_t al256(size_t x) { return (x + 255) & ~(size_t)255; }
constexpr size_t OFF_CTL = 0, CTL_BYTES = 65536;
constexpr size_t OFF_MOD = OFF_CTL + CTL_BYTES;
constexpr size_t OFF_TABH = al256(OFF_MOD + (size_t)2 * 9 * 6144 * 4);
constexpr size_t OFF_TABR = al256(OFF_TABH + (size_t)2048 * 32 * 8);
constexpr size_t OFF_WIN = al256(OFF_TABR + (size_t)2048 * 16 * 8);
constexpr size_t OFF_WOUT = al256(OFF_WIN + (size_t)2 * NP * 1024 * 2);
constexpr size_t OFF_WKV = al256(OFF_WOUT + (size_t)2 * 1024 * 1024 * 2);
constexpr size_t OFF_XC = al256(OFF_WKV + (size_t)2 * 512 * 128 * 2);
constexpr size_t OFF_E8 = al256(OFF_XC + (size_t)T_CTX * 1024 * 4);
constexpr size_t OFF_W8 = al256(OFF_E8 + (size_t)T_ALL * 8);
constexpr size_t OFF_LR8 = al256(OFF_W8 + (size_t)T_ALL * 8 * 4);
constexpr size_t OFF_TSL = al256(OFF_LR8 + (size_t)T_ALL * 8 * 2);
constexpr size_t OFF_STK = al256(OFF_TSL + (size_t)T_ALL * 8 * 4);
constexpr size_t OFF_HIST = al256(OFF_STK + (size_t)RSLOTS * 4);
constexpr size_t OFF_TOFF = al256(OFF_HIST + (size_t)MAX_RT * 64 * 4);
constexpr size_t OFF_CNT = al256(OFF_TOFF + (size_t)MAX_RT * 64 * 4);
constexpr size_t OFF_WD = al256(OFF_CNT + 256);
constexpr size_t OFF_H = al256(OFF_WD + (size_t)65 * 1024 * 256 * 2);
constexpr size_t OFF_ACT = al256(OFF_H + (size_t)T_ALL * 1024 * 2);
constexpr size_t OFF_WGU = al256(OFF_ACT + (size_t)ACT_ROWS * 256 * 2);
constexpr size_t OFF_Y = OFF_WGU;
constexpr size_t OFF_P = al256(OFF_WGU + (size_t)65 * 512 * 1024 * 2);
constexpr size_t OFF_KVB = al256(OFF_P + (size_t)T_ALL * NP * 2);
constexpr size_t OFF_MIXIN = al256(OFF_KVB + (size_t)T_ALL * NKV * 2);
constexpr size_t OFF_MIX = al256(OFF_MIXIN + (size_t)T_ALL * 1024 * 2);
constexpr size_t ATT_END = al256(OFF_MIX + (size_t)T_ALL * 1024 * 2);
constexpr size_t Y_END = al256(OFF_Y + (size_t)RSLOTS * 1024 * 2);
constexpr size_t WS_NEED = (ATT_END > Y_END ? ATT_END : Y_END);

constexpr int LDS_BYTES = 69632;
constexpr int LDS_XB = LDS_BYTES - 16;

struct Params {
    const float *x, *c, *ctx, *c_ctx, *ada_w, *ada_b, *pre_mix_g, *post_mix_g, *pre_ffn_g, *post_ffn_g, *w_in, *a_q_norm, *a_k_norm,
        *b_kv_norm, *b_w_kv_up, *c_sink, *d_rpb, *w_out, *router_w, *router_b, *exp_w_gate, *exp_w_up, *exp_w_down, *sh_w_gate, *sh_w_up, *sh_w_down;
    float* out; char* ws; int ph_lo, ph_hi;
};

DEVI unsigned pk2(float lo, float hi) { f32x2 v = {lo, hi}; bf16x2_t b = __builtin_convertvector(v, bf16x2_t); return __builtin_bit_cast(unsigned, b); }
DEVI float bflo(unsigned u) { return __uint_as_float(u << 16); }
DEVI float bfhi(unsigned u) { return __uint_as_float(u & 0xffff0000u); }
DEVI float wave_sum(float v) {
#pragma unroll
    for (int o = 32; o; o >>= 1) v += __shfl_xor(v, o);
    return v;
}
DEVI int ltid() { int t = threadIdx.x; asm volatile("" : "+v"(t)); return t; }
DEVI float fexp2(float x) { return __builtin_amdgcn_exp2f(x); }
DEVI float silu_f(float x) { return x / (1.f + __expf(-x)); }

#define XB_TMO      128
#define XB_XCNT(j)  (256  + 64 * (j))
#define XB_XSUB(j)  (1280 + 64 * (j))
#define XB_XGEN(j)  (2304 + 64 * (j))
#define XB_TOP      3328
#define XB_TOPGEN   3392
#define XCD_BAR_WORDS 3456
#define XB_SPIN_CAP (1u << 18)

DEVI unsigned xb_ld(unsigned* p)              { return __hip_atomic_load(p, __ATOMIC_RELAXED, __HIP_MEMORY_SCOPE_AGENT); }
DEVI unsigned xb_add(unsigned* p, unsigned v) { return __hip_atomic_fetch_add(p, v, __ATOMIC_RELAXED, __HIP_MEMORY_SCOPE_AGENT); }
DEVI unsigned xb_xcc_id() { return (unsigned)__builtin_amdgcn_s_getreg((3 << 11) | 20) & 0xFu; }
#define XB_SPIN(cond, bar) do { unsigned _sp = 0; while (cond) { __builtin_amdgcn_s_sleep(1); \
    if ((++_sp & 255u) == 0u) { if (xb_ld(&(bar)[XB_TMO])) break; if (_sp > XB_SPIN_CAP) { atomicAdd(&(bar)[XB_TMO], 1u); break; } } } } while (0)

struct XcdBarrier { unsigned* bar; unsigned x; volatile LAS unsigned* st; };

DEVI XcdBarrier xcd_barrier_post(unsigned* bar, volatile LAS unsigned* st) {
    XcdBarrier b; b.bar = bar; b.x = xb_xcc_id(); b.st = st;
    if (threadIdx.x == 0) (void)xb_add(&bar[XB_XCNT(b.x)], 1u);
    return b;
}
DEVI void xcd_barrier_complete(unsigned* bar, unsigned x, unsigned& nloc, unsigned& nx) {
    const unsigned G = gridDim.x * gridDim.y * gridDim.z;
    unsigned sum, cnt, mine, sp = 0u;
    for (;;) {
        sum = 0u; cnt = 0u; mine = 0u;
#pragma unroll
        for (unsigned j = 0; j < 16; ++j) { const unsigned c = xb_ld(&bar[XB_XCNT(j)]); sum += c; cnt += (c > 0u) ? 1u : 0u; mine = (j == x) ? c : mine; }
        if (sum == G) break;
        __builtin_amdgcn_s_sleep(1);
        if ((++sp & 255u) == 0u) { if (xb_ld(&bar[XB_TMO])) break; if (sp > XB_SPIN_CAP) { atomicAdd(&bar[XB_TMO], 1u); break; } }
    }
    nloc = mine > 0u ? mine : 1u; nx = cnt > 0u ? cnt : 1u;
}
DEVI void xcd_barrier(const XcdBarrier& b) {
    asm volatile("s_waitcnt vmcnt(0)" ::: "memory");
    __syncthreads();
    if (threadIdx.x == 0) {
        unsigned* bar = b.bar;
        __builtin_amdgcn_s_waitcnt(0);
        unsigned nloc = b.st[0], nx = b.st[1];
        if (nloc == 0u) { xcd_barrier_complete(bar, b.x, nloc, nx); b.st[0] = nloc; b.st[1] = nx; }
        const unsigned old = xb_add(&bar[XB_XSUB(b.x)], 1u);
        const unsigned gen = old / nloc;
        if (old + 1u == (gen + 1u) * nloc) {
            __builtin_amdgcn_fence(__ATOMIC_RELEASE, "agent");
            asm volatile("s_waitcnt vmcnt(0)" ::: "memory");
            const unsigned og = xb_add(&bar[XB_TOP], 1u);
            const unsigned tg = og / nx;
            if (og + 1u == (tg + 1u) * nx) xb_add(&bar[XB_TOPGEN], 1u);
            else XB_SPIN(xb_ld(&bar[XB_TOPGEN]) == tg, bar);
            __builtin_amdgcn_fence(__ATOMIC_ACQUIRE, "agent");
            xb_add(&bar[XB_XGEN(b.x)], 1u);
            asm volatile("s_waitcnt vmcnt(0)" ::: "memory");
        } else {
            XB_SPIN(xb_ld(&bar[XB_XGEN(b.x)]) == gen, bar);
            __builtin_amdgcn_fence(__ATOMIC_ACQUIRE, "agent");
            asm volatile("s_waitcnt vmcnt(0)" ::: "memory");
        }
    }
    __syncthreads();
}

DEVI int lds_byte(int r, int c) { const int st = (r >> 4) * 2 + (c >> 5), rr = r & 15, cc = c & 31, ob = rr * 64 + cc * 2; return st * 1024 + (ob ^ (((ob >> 9) & 1) << 5)); }
DEVI void stage_rc(int b, int& R, int& C) { const int st = b / 1024, sb = b % 1024, swz = sb ^ (((sb >> 9) & 1) << 5); R = (st >> 1) * 16 + swz / 64; C = (st & 1) * 32 + (swz % 64) / 2; }

DEVI void glds16(const void* g, lchar* l) {
    __builtin_amdgcn_global_load_lds((const __attribute__((address_space(1))) unsigned*)g, (LAS unsigned*)l, 16, 0, 0);
}

template <class AF>
DEVI void gemm_main(lchar* lds, const AF& arow, const bf16_t* Bt, int ldb, int nkt, f32x4 (&acc)[4][4]) {
    const int tid = ltid(), wid = tid >> 6, lane = tid & 63, wr = wid >> 1, wc = wid & 1, fr = lane & 15, fq = lane >> 4;
    const bf16_t* ap[4]; const bf16_t* bp[4];
#pragma unroll
    for (int i = 0; i < 4; ++i) { int R, C; stage_rc(tid * 16 + i * 4096, R, C); ap[i] = arow(R) + C; bp[i] = Bt + (size_t)R * ldb + C; }
    lchar* sA = lds + wid * 1024; lchar* sB = lds + 32768 + wid * 1024;
#pragma unroll
    for (int m = 0; m < 4; ++m)
#pragma unroll
        for (int n = 0; n < 4; ++n) acc[m][n] = (f32x4){0.f, 0.f, 0.f, 0.f};
    const int aoff = lds_byte(wr * 64 + fr, fq * 8), boff = lds_byte(wc * 64 + fr, fq * 8);
#pragma unroll
    for (int i = 0; i < 4; ++i) { glds16(ap[i], sA + i * 4096); glds16(bp[i], sB + i * 4096); }
    for (int t = 0; t < nkt; ++t) {
        const int cur = t & 1;
        asm volatile("s_waitcnt vmcnt(0)" ::: "memory");
        __syncthreads();
        if (t + 1 < nkt) {
            const int nb = (cur ^ 1) * 16384, ko = (t + 1) * 64;
#pragma unroll
            for (int i = 0; i < 4; ++i) { glds16(ap[i] + ko, sA + nb + i * 4096); glds16(bp[i] + ko, sB + nb + i * 4096); }
        }
        const lchar* A = lds + cur * 16384 + aoff; const lchar* B = lds + 32768 + cur * 16384 + boff;
#pragma unroll
        for (int ks = 0; ks < 2; ++ks) {
            bf16x8 a[4], b[4];
#pragma unroll
            for (int m = 0; m < 4; ++m) a[m] = *(const LAS bf16x8*)(A + m * 2048 + ks * 1024);
#pragma unroll
            for (int n = 0; n < 4; ++n) b[n] = *(const LAS bf16x8*)(B + n * 2048 + ks * 1024);
#pragma unroll
            for (int m = 0; m < 4; ++m)
#pragma unroll
                for (int n = 0; n < 4; ++n) acc[m][n] = __builtin_amdgcn_mfma_f32_16x16x32_bf16(b[n], a[m], acc[m][n], 0, 0, 0);
        }
    }
    __syncthreads();
}

template <int NCOLS>
DEVI void tile_store(lchar* lds, bf16_t* out, size_t ld, int nrows_valid = 128) {
    constexpr int RS = NCOLS * 2 + 16, CPR = NCOLS / 8;
    __syncthreads();
    for (int c = ltid(); c < 128 * CPR; c += 256) {
        const int r = c / CPR, pc = c % CPR;
        if (r < nrows_valid) { const u32x4 v = *(const LAS u32x4*)(lds + r * RS + pc * 16); *(u32x4*)(out + (size_t)r * ld + pc * 8) = v; }
    }
    __syncthreads();
}

struct SrcRow { const float* p; int stride; };

template <class RF>
DEVI void conv_tile(lchar* lds, const RF& rf, int n0, int k0, bf16_t* dst, int K, const float* kscale) {
    LAS float* t = (LAS float*)lds;
    const int tid = ltid(), nn = tid & 63, kq = tid >> 6;
    const SrcRow sr = rf(n0 + nn);
#pragma unroll
    for (int i = 0; i < 16; ++i) {
        const int kk = kq + i * 4;
        float v = sr.p ? sr.p[(size_t)(k0 + kk) * sr.stride] : 0.f;
        if (kscale) v *= kscale[k0 + kk];
        t[kk * 65 + nn] = v;
    }
    __syncthreads();
#pragma unroll
    for (int i = 0; i < 2; ++i) {
        const int idx = tid + i * 256, r = idx >> 3, kc = idx & 7;
        unsigned w[4];
#pragma unroll
        for (int q = 0; q < 4; ++q) w[q] = pk2(t[(kc * 8 + 2 * q) * 65 + r], t[(kc * 8 + 2 * q + 1) * 65 + r]);
        *(uint4*)(dst + (size_t)(n0 + r) * K + k0 + kc * 8) = make_uint4(w[0], w[1], w[2], w[3]);
    }
    __syncthreads();
}

DEVI int rope32_orig(int i) { const int seg = i >> 3, w = i & 7; return (seg == 0 ? 0 : seg == 1 ? 16 : seg == 2 ? 8 : 24) + w; }
DEVI int win_src_col(int r) {
    if (r < 512) return r;
    if (r < 768) { const int h = (r - 512) >> 6, i = (r - 512) & 63; return 512 + h * 96 + i; }
    if (r < 896) { const int h = (r - 768) >> 5, i = (r - 768) & 31; return 512 + h * 96 + 64 + rope32_orig(i); }
    if (r < 1024) return r;
    if (r < 2304) return r + 32;
    if (r < 2336) return 1024 + rope32_orig(r - 2304);
    return -1;
}

constexpr int CT_WIN = (NP / 64) * 16, CT_WOUT = 16 * 16, CT_WKV = 8 * 2, CT_SMALL = CT_WIN + CT_WOUT + CT_WKV;
constexpr int CT_GU = 65 * 128, CT_DN = 65 * 64, CT_EXP = CT_GU + CT_DN;

DEVI void conv_small_tile(lchar* lds, const Params& p, int l, int t) {
    char* ws = p.ws;
    if (t < CT_WIN) {
        const int n0 = (t / 16) * 64, k0 = (t % 16) * 64;
        const float* src = p.w_in + (size_t)l * 1024 * IN_W;
        auto rf = [&](int r) { const int c = win_src_col(r); SrcRow s; s.p = c >= 0 ? src + c : nullptr; s.stride = IN_W; return s; };
        conv_tile(lds, rf, n0, k0, (bf16_t*)(ws + OFF_WIN) + (size_t)l * NP * 1024, 1024, nullptr);
    } else if (t < CT_WIN + CT_WOUT) {
        t -= CT_WIN;
        const int n0 = (t / 16) * 64, k0 = (t % 16) * 64;
        const float* src = p.w_out + (size_t)l * 1024 * 1024;
        auto rf = [&](int r) { SrcRow s; s.p = src + r; s.stride = 1024; return s; };
        conv_tile(lds, rf, n0, k0, (bf16_t*)(ws + OFF_WOUT) + (size_t)l * 1024 * 1024, 1024, nullptr);
    } else {
        t -= CT_WIN + CT_WOUT;
        const int n0 = (t / 2) * 64, k0 = (t % 2) * 64;
        const float* src = p.b_w_kv_up + (size_t)l * 128 * 512;
        auto rf = [&](int r) { SrcRow s; s.p = src + r; s.stride = 512; return s; };
        conv_tile(lds, rf, n0, k0, (bf16_t*)(ws + OFF_WKV) + (size_t)l * 512 * 128, 128, p.b_kv_norm + l * 128);
    }
}
DEVI void conv_exp_tile(lchar* lds, const Params& p, int l, int t) {
    char* ws = p.ws;
    if (t < CT_GU) {
        const int e = t / 128, tt = t % 128, n0 = (tt / 16) * 64, k0 = (tt % 16) * 64;
        const float* g = e < 64 ? p.exp_w_gate + ((size_t)l * 64 + e) * 1024 * 256 : p.sh_w_gate + (size_t)l * 1024 * 256;
        const float* u = e < 64 ? p.exp_w_up + ((size_t)l * 64 + e) * 1024 * 256 : p.sh_w_up + (size_t)l * 1024 * 256;
        auto rf = [&](int r) { const int nt = r >> 7, wc = (r >> 6) & 1, n = (r >> 4) & 3, i = r & 15; SrcRow s; s.p = ((n & 1) ? u : g) + nt * 64 + wc * 32 + (n >> 1) * 16 + i; s.stride = 256; return s; };
        conv_tile(lds, rf, n0, k0, (bf16_t*)(ws + OFF_WGU) + (size_t)e * 512 * 1024, 1024, nullptr);
    } else {
        t -= CT_GU;
        const int e = t / 64, tt = t % 64, n0 = (tt / 4) * 64, k0 = (tt % 4) * 64;
        const float* d = e < 64 ? p.exp_w_down + ((size_t)l * 64 + e) * 256 * 1024 : p.sh_w_down + (size_t)l * 256 * 1024;
        auto rf = [&](int r) { SrcRow s; s.p = d + r; s.stride = 1024; return s; };
        conv_tile(lds, rf, n0, k0, (bf16_t*)(ws + OFF_WD) + (size_t)e * 1024 * 256, 256, nullptr);
    }
}

DEVI void ada_unit(lchar* lds, const Params& p, int u) {
    LAS float* ca = (LAS float*)lds;
    LAS float* red = (LAS float*)(lds + 9 * 1024 * 4);
    const int tid = ltid(), l = u / 96, cg = u % 96, col = cg * 64 + (tid & 63), kq = tid >> 6;
    for (int i = tid; i < 9 * 1024; i += 256) { const float v = i < 8192 ? p.c[i] : p.c_ctx[i - 8192]; ca[i] = silu_f(v); }
    __syncthreads();
    float acc[9];
#pragma unroll
    for (int b = 0; b < 9; ++b) acc[b] = 0.f;
    const float* w = p.ada_w + (size_t)l * 1024 * 6144 + col;
    for (int k = kq * 256; k < kq * 256 + 256; ++k) {
        const float wv = w[(size_t)k * 6144];
#pragma unroll
        for (int b = 0; b < 9; ++b) acc[b] += ca[b * 1024 + k] * wv;
    }
#pragma unroll
    for (int b = 0; b < 9; ++b) red[(kq * 9 + b) * 64 + (tid & 63)] = acc[b];
    __syncthreads();
    float* mod = (float*)(p.ws + OFF_MOD);
    for (int i = tid; i < 9 * 64; i += 256) {
        const int b = i >> 6, c = i & 63;
        const float s = ((red[(0 * 9 + b) * 64 + c] + red[(1 * 9 + b) * 64 + c]) + red[(2 * 9 + b) * 64 + c]) + red[(3 * 9 + b) * 64 + c];
        mod[((size_t)l * 9 + b) * 6144 + cg * 64 + c] = s + p.ada_b[l * 6144 + cg * 64 + c];
    }
    __syncthreads();
}

DEVI void rope_tables(const Params& p, int gtid, int gn) {
    float2* th = (float2*)(p.ws + OFF_TABH); float2* tr = (float2*)(p.ws + OFF_TABR);
    for (int i = gtid; i < 2048 * 48; i += gn) {
        const int pos = i / 48, a = i % 48;
        const double row = (double)(pos / 64), col = (double)(pos % 64);
        double ang;
        if (a < 32) { const int q = a & 15; ang = ((a < 16) ? row : col) * pow(10000.0, -(double)q / 16.0); }
        else { const int aa = a - 32, q = aa & 7; ang = ((aa < 8) ? row : col) * pow(10000.0, -(double)q / 8.0); }
        const float2 v = make_float2((float)cos(ang), (float)sin(ang));
        if (a < 32) th[pos * 32 + a] = v; else tr[pos * 16 + (a - 32)] = v;
    }
}

DEVI void phase_s0(lchar* lds, const Params& p) {
    const int G = gridDim.x, bid = blockIdx.x;
    rope_tables(p, bid * 256 + ltid(), G * 256);
    for (int u = bid; u < 192; u += G) ada_unit(lds, p, u);
    for (int t = bid; t < 2 * CT_SMALL; t += G) conv_small_tile(lds, p, t / CT_SMALL, t % CT_SMALL);
    for (int t = bid; t < CT_EXP; t += G) conv_exp_tile(lds, p, 0, t);
}

DEVI const float* xrow_ptr(const Params& p, int l, int r) {
    if (r < T_LAT) return (l == 0 ? p.x : p.out) + (size_t)r * 1024;
    return (l == 0 ? p.ctx : (const float*)(p.ws + OFF_XC)) + (size_t)(r - T_LAT) * 1024;
}
DEVI void phase_s1(const Params& p, int l) {
    const int wid = ltid() >> 6, lane = ltid() & 63;
    const int gw = blockIdx.x * 4 + wid, nw = gridDim.x * 4;
    const float* g = p.pre_mix_g + l * 1024;
    bf16_t* H = (bf16_t*)(p.ws + OFF_H);
    for (int r = gw; r < T_ALL; r += nw) {
        const float* xr = xrow_ptr(p, l, r);
        const int bb = r < T_LAT ? (r >> 11) : 8;
        const float* mod = (const float*)(p.ws + OFF_MOD) + ((size_t)l * 9 + bb) * 6144;
        float4 v[4]; float ss = 0.f;
#pragma unroll
        for (int i = 0; i < 4; ++i) { v[i] = *(const float4*)(xr + i * 256 + lane * 4); ss += v[i].x * v[i].x + v[i].y * v[i].y + v[i].z * v[i].z + v[i].w * v[i].w; }
        ss = wave_sum(ss);
        const float rs = rsqrtf(ss * (1.f / 1024.f) + EPS);
#pragma unroll
        for (int i = 0; i < 4; ++i) {
            const int c = i * 256 + lane * 4;
            const float4 gg = *(const float4*)(g + c), sh = *(const float4*)(mod + c), sc = *(const float4*)(mod + 1024 + c);
            const float a0 = v[i].x * rs * gg.x * (1.f + sc.x) + sh.x, a1 = v[i].y * rs * gg.y * (1.f + sc.y) + sh.y;
            const float a2 = v[i].z * rs * gg.z * (1.f + sc.z) + sh.z, a3 = v[i].w * rs * gg.w * (1.f + sc.w) + sh.w;
            *(uint2*)(H + (size_t)r * 1024 + c) = make_uint2(pk2(a0, a1), pk2(a2, a3));
        }
    }
}

DEVI void acc_to_lds128(lchar* lds, const f32x4 (&acc)[4][4]) {
    const int tid = ltid(), wid = tid >> 6, lane = tid & 63, wr = wid >> 1, wc = wid & 1, fr = lane & 15, fq = lane >> 4;
#pragma unroll
    for (int m = 0; m < 4; ++m)
#pragma unroll
        for (int n = 0; n < 4; ++n) {
            u32x2 v = {pk2(acc[m][n][0], acc[m][n][1]), pk2(acc[m][n][2], acc[m][n][3])};
            *(LAS u32x2*)(lds + (wr * 64 + m * 16 + fr) * 272 + (wc * 64 + n * 16 + fq * 4) * 2) = v;
        }
}

DEVI void inproj_unit(lchar* lds, const Params& p, int l, int mt, int nt) {
    const int tid = ltid(), wid = tid >> 6, lane = tid & 63, wr = wid >> 1, wc = wid & 1, fr = lane & 15, fq = lane >> 4;
    const bf16_t* H = (const bf16_t*)(p.ws + OFF_H) + (size_t)mt * 128 * 1024;
    const bf16_t* W = (const bf16_t*)(p.ws + OFF_WIN) + ((size_t)l * NP + nt * 128) * 1024;
    auto arow = [&](int R) { return H + (size_t)R * 1024; };
    f32x4 acc[4][4];
    gemm_main(lds, arow, W, 1024, 16, acc);
    const int g = nt * 2 + wc;
    const bool lat = mt < (T_LAT / 128);
    const bool do_norm = g < 6;
    const int rope = ((g < 6) || (g >= 16 && g < 22)) ? 1 : ((g == 12 || g == 13 || g == 36) ? 2 : 0);
    const float SA = 0.125f * LOG2E, SB = 0.10206207261596577f * LOG2E;
    const float scale = ((g < 4) || (g >= 16 && g < 20) || (g >= 24 && g < 28)) ? SA : ((g >= 8 && g < 14) ? SB : 1.f);
    if (do_norm) {
        const float* gn = (g < 4 ? p.a_q_norm : p.a_k_norm) + l * 64;
        float gv[4][4];
#pragma unroll
        for (int n = 0; n < 4; ++n)
#pragma unroll
            for (int j = 0; j < 4; ++j) gv[n][j] = gn[n * 16 + fq * 4 + j];
#pragma unroll
        for (int m = 0; m < 4; ++m) {
            float ss = 0.f;
#pragma unroll
            for (int n = 0; n < 4; ++n)
#pragma unroll
                for (int j = 0; j < 4; ++j) ss += acc[m][n][j] * acc[m][n][j];
            ss += __shfl_xor(ss, 16); ss += __shfl_xor(ss, 32);
            const float rs = rsqrtf(ss * (1.f / 64.f) + EPS);
#pragma unroll
            for (int n = 0; n < 4; ++n)
#pragma unroll
                for (int j = 0; j < 4; ++j) acc[m][n][j] *= rs * gv[n][j];
        }
    }
    if (rope != 0 && lat) {
        const float* tab = (const float*)(p.ws + (rope == 1 ? OFF_TABH : OFF_TABR));
        const int tw = rope == 1 ? 32 : 16;
#pragma unroll
        for (int m = 0; m < 4; ++m) {
            const int pos = (mt * 128 + wr * 64 + m * 16 + fr) & 2047;
#pragma unroll
            for (int hf = 0; hf < 2; ++hf) {
                const int a0 = (rope == 1 ? hf * 16 : 0) + fq * 4;
                const float4 t0 = *(const float4*)(tab + ((size_t)pos * tw + a0) * 2), t1 = *(const float4*)(tab + ((size_t)pos * tw + a0) * 2 + 4);
                const float cs[4] = {t0.x, t0.z, t1.x, t1.z}, sn[4] = {t0.y, t0.w, t1.y, t1.w};
#pragma unroll
                for (int j = 0; j < 4; ++j) {
                    const float x1 = acc[m][2 * hf][j], x2 = acc[m][2 * hf + 1][j];
                    acc[m][2 * hf][j] = x1 * cs[j] - x2 * sn[j];
                    acc[m][2 * hf + 1][j] = x2 * cs[j] + x1 * sn[j];
                }
            }
        }
    }
    if (scale != 1.f) {
#pragma unroll
        for (int m = 0; m < 4; ++m)
#pragma unroll
            for (int n = 0; n < 4; ++n) acc[m][n] *= scale;
    }
    acc_to_lds128(lds, acc);
    tile_store<128>(lds, (bf16_t*)(p.ws + OFF_P) + (size_t)mt * 128 * NP + nt * 128, NP);
}

DEVI void kvup_unit(lchar* lds, const Params& p, int l, int mt, int nt) {
    const int tid = ltid(), wid = tid >> 6, lane = tid & 63, wr = wid >> 1, fr = lane & 15;
    const bf16_t* A = (const bf16_t*)(p.ws + OFF_P) + (size_t)mt * 128 * NP + PC_CKV;
    LAS float* rsv = (LAS float*)(lds + 65536);
    {
        const int r = tid >> 1, hf = tid & 1;
        const u32x4* src = (const u32x4*)(A + (size_t)r * NP + hf * 64);
        float ss = 0.f;
#pragma unroll
        for (int i = 0; i < 8; ++i) { const u32x4 v = src[i];
#pragma unroll
            for (int q = 0; q < 4; ++q) { const float a = bflo(v[q]), b = bfhi(v[q]); ss += a * a + b * b; } }
        ss += __shfl_xor(ss, 1);
        if (hf == 0) rsv[r] = rsqrtf(ss * (1.f / 128.f) + EPS);
    }
    const bf16_t* W = (const bf16_t*)(p.ws + OFF_WKV) + ((size_t)l * 512 + nt * 128) * 128;
    auto arow = [&](int R) { return A + (size_t)R * NP; };
    f32x4 acc[4][4];
    gemm_main(lds, arow, W, 128, 2, acc);
#pragma unroll
    for (int m = 0; m < 4; ++m) { const float rs = rsv[wr * 64 + m * 16 + fr];
#pragma unroll
        for (int n = 0; n < 4; ++n) acc[m][n] *= rs; }
    acc_to_lds128(lds, acc);
    tile_store<128>(lds, (bf16_t*)(p.ws + OFF_KVB) + (size_t)mt * 128 * NKV + nt * 128, NKV);
}

DEVI void outproj_unit(lchar* lds, const Params& p, int l, int mt, int nt) {
    const bf16_t* A = (const bf16_t*)(p.ws + OFF_MIXIN) + (size_t)mt * 128 * 1024;
    const bf16_t* W = (const bf16_t*)(p.ws + OFF_WOUT) + ((size_t)l * 1024 + nt * 128) * 1024;
    auto arow = [&](int R) { return A + (size_t)R * 1024; };
    f32x4 acc[4][4];
    gemm_main(lds, arow, W, 1024, 16, acc);
    acc_to_lds128(lds, acc);
    tile_store<128>(lds, (bf16_t*)(p.ws + OFF_MIX) + (size_t)mt * 128 * 1024 + nt * 128, 1024);
}

DEVI void build_seg(lchar* lds, const Params& p) {
    LAS int* seg = (LAS int*)(lds + 66048);
    const int* cnt = (const int*)(p.ws + OFF_CNT);
    if (ltid() == 0) { int s = 0; for (int e = 0; e < 64; ++e) { seg[e] = s; s += (cnt[e] + 127) & ~127; } seg[64] = s; }
    __syncthreads();
}
DEVI int seg_expert(lchar* lds, int slot) {
    LAS int* seg = (LAS int*)(lds + 66048);
    int e = 0;
#pragma unroll
    for (int s = 32; s; s >>= 1) if (seg[e + s] <= slot) e += s;
    return e;
}

DEVI void gateup_unit(lchar* lds, const Params& p, int mt, int nt, int nmt_r) {
    const int tid = ltid(), wid = tid >> 6, lane = tid & 63, wr = wid >> 1, wc = wid & 1, fr = lane & 15, fq = lane >> 4;
    const bf16_t* H = (const bf16_t*)(p.ws + OFF_H);
    const int* stk = (const int*)(p.ws + OFF_STK);
    int e, row0; bool shared = mt >= nmt_r;
    if (shared) { e = 64; row0 = SH_BASE + (mt - nmt_r) * 128; } else { e = seg_expert(lds, mt * 128); row0 = mt * 128; }
    const bf16_t* W = (const bf16_t*)(p.ws + OFF_WGU) + ((size_t)e * 512 + nt * 128) * 1024;
    f32x4 acc[4][4];
    if (shared) { const bf16_t* A = H + (size_t)(mt - nmt_r) * 128 * 1024; auto arow = [&](int R) { return A + (size_t)R * 1024; }; gemm_main(lds, arow, W, 1024, 16, acc); }
    else { auto arow = [&](int R) { return H + (size_t)stk[row0 + R] * 1024; }; gemm_main(lds, arow, W, 1024, 16, acc); }
#pragma unroll
    for (int m = 0; m < 4; ++m)
#pragma unroll
        for (int hf = 0; hf < 2; ++hf) {
            float a[4];
#pragma unroll
            for (int j = 0; j < 4; ++j) a[j] = silu_f(acc[m][2 * hf][j]) * acc[m][2 * hf + 1][j];
            u32x2 v = {pk2(a[0], a[1]), pk2(a[2], a[3])};
            *(LAS u32x2*)(lds + (wr * 64 + m * 16 + fr) * 144 + (wc * 32 + hf * 16 + fq * 4) * 2) = v;
        }
    tile_store<64>(lds, (bf16_t*)(p.ws + OFF_ACT) + (size_t)row0 * 256 + nt * 64, 256);
}

DEVI void down_unit(lchar* lds, const Params& p, int mt, int nt, int nmt_r) {
    int e, row0; bool shared = mt >= nmt_r;
    if (shared) { e = 64; row0 = SH_BASE + (mt - nmt_r) * 128; } else { e = seg_expert(lds, mt * 128); row0 = mt * 128; }
    const bf16_t* A = (const bf16_t*)(p.ws + OFF_ACT) + (size_t)row0 * 256;
    const bf16_t* W = (const bf16_t*)(p.ws + OFF_WD) + ((size_t)e * 1024 + nt * 128) * 256;
    auto arow = [&](int R) { return A + (size_t)R * 256; };
    f32x4 acc[4][4];
    gemm_main(lds, arow, W, 256, 4, acc);
    acc_to_lds128(lds, acc);
    bf16_t* out = shared ? (bf16_t*)(p.ws + OFF_H) + (size_t)(mt - nmt_r) * 128 * 1024 : (bf16_t*)(p.ws + OFF_Y) + (size_t)row0 * 1024;
    tile_store<128>(lds, out + nt * 128, 1024);
}

typedef short v4i16 __attribute__((ext_vector_type(4)));
template <int MODE>
DEVI void attn_unit(lchar* lds, const Params& p, int l, int b, int h, int qi, bool ctxq) {
    constexpr int DK = MODE == 1 ? 96 : 64, QG = MODE == 3 ? 1 : 2, KS = DK * 2 + 16, VS = 144, NKS = DK / 32;
    constexpr int KBUF = 64 * KS, VBUF = 64 * VS, OFFV = 2 * KBUF, OFFB = OFFV + 2 * VBUF;
    constexpr int KCH = (64 * DK * 2 / 16) / 256;
    const int tid = ltid(), wid = tid >> 6, lane = tid & 63, fr = lane & 15, fq = lane >> 4;
    const bf16_t* P = (const bf16_t*)(p.ws + OFF_P);
    const bf16_t* KVB = (const bf16_t*)(p.ws + OFF_KVB);
    const int qcol = MODE == 0 ? PC_AQ + h * 64 : MODE == 1 ? PC_BQN + h * 64 : MODE == 2 ? PC_CQ + h * 64 : PC_DQ + h * 64;
    const int kcol = MODE == 0 ? PC_AK + (h >> 1) * 64 : MODE == 2 ? PC_CK + (h >> 1) * 64 : PC_DK + h * 64;
    const int vcol = MODE == 0 ? PC_AV + (h >> 1) * 64 : MODE == 2 ? PC_CV + (h >> 1) * 64 : PC_DV + h * 64;
    const int ocol = MODE * 256 + h * 64;
    const int qrow0 = ctxq ? T_LAT + b * CTXL + qi * (QG * 64) + wid * (QG * 16)
                           : (MODE == 3 ? b * SEQ + qi * 64 + wid * 16 : b * SEQ + qi * 128 + wid * 32);
    bf16x8 qf[QG][NKS];
#pragma unroll
    for (int g = 0; g < QG; ++g)
#pragma unroll
        for (int ks = 0; ks < NKS; ++ks) {
            const size_t row = (size_t)(qrow0 + g * 16 + fr);
            const bf16_t* ptr = (MODE == 1 && ks == 2) ? P + row * NP + PC_BQR + h * 32 + fq * 8 : P + row * NP + qcol + ks * 32 + fq * 8;
            qf[g][ks] = *(const bf16x8*)ptr;
        }
    int nlat = 0, lat0 = 0, rs = 0;
    if (!ctxq) {
        if (MODE == 0 || MODE == 1) { nlat = 32; lat0 = 0; }
        else if (MODE == 2) { const int k0 = max(0, qi * 128 - 128), k1 = min(SEQ, qi * 128 + 256); nlat = (k1 - k0) >> 6; lat0 = k0; }
        else { rs = min(max(qi - 4, 0), 24); nlat = 8; lat0 = rs * 64; }
    }
    const int ntile = 4 + nlat;
    LAS float* btab = (LAS float*)(lds + OFFB);
    if (MODE == 3) { const float* rpb = p.d_rpb + (size_t)(l * 4 + h) * 465; for (int i = tid; i < 465; i += 256) btab[i] = rpb[i] * LOG2E; }
    float mrun[QG], lrun[QG]; f32x4 o[QG][4];
#pragma unroll
    for (int g = 0; g < QG; ++g) {
        mrun[g] = -1e30f; lrun[g] = 0.f;
        if (MODE == 2) { mrun[g] = p.c_sink[l * 4 + h] * LOG2E; lrun[g] = fq == 0 ? 1.f : 0.f; }
#pragma unroll
        for (int d = 0; d < 4; ++d) o[g][d] = (f32x4){0.f, 0.f, 0.f, 0.f};
    }
    u32x4 kreg[KCH], vreg[2];
    auto tile_row = [&](int t) { return t < 4 ? T_LAT + b * CTXL + t * 64 : b * SEQ + lat0 + (t - 4) * 64; };
    auto load_tile = [&](int t) {
        const size_t r0 = (size_t)tile_row(t);
#pragma unroll
        for (int i = 0; i < KCH; ++i) {
            const int c = tid + 256 * i;
            if (MODE == 1) { const int row = c / 12, pc = c % 12;
                const bf16_t* src = pc < 8 ? KVB + (r0 + row) * NKV + h * 128 + pc * 8 : P + (r0 + row) * NP + PC_BKR + (pc - 8) * 8;
                kreg[i] = *(const u32x4*)src;
            } else { const int row = c >> 3, pc = c & 7; kreg[i] = *(const u32x4*)(P + (r0 + row) * NP + kcol + pc * 8); }
        }
#pragma unroll
        for (int i = 0; i < 2; ++i) {
            const int c = tid + 256 * i, row = c >> 3, pc = c & 7;
            const bf16_t* src = MODE == 1 ? KVB + (r0 + row) * NKV + h * 128 + 64 + pc * 8 : P + (r0 + row) * NP + vcol + pc * 8;
            vreg[i] = *(const u32x4*)src;
        }
    };
    auto write_tile = [&](int buf) {
#pragma unroll
        for (int i = 0; i < KCH; ++i) {
            const int c = tid + 256 * i;
            const int row = MODE == 1 ? c / 12 : c >> 3, pc = MODE == 1 ? c % 12 : c & 7;
            *(LAS u32x4*)(lds + buf * KBUF + row * KS + pc * 16) = kreg[i];
        }
#pragma unroll
        for (int i = 0; i < 2; ++i) { const int c = tid + 256 * i, row = c >> 3, pc = c & 7; *(LAS u32x4*)(lds + OFFV + buf * VBUF + row * VS + pc * 16) = vreg[i]; }
    };
    load_tile(0); write_tile(0);
    __syncthreads();
    for (int t = 0; t < ntile; ++t) {
        if (t + 1 < ntile) load_tile(t + 1);
        const lchar* Kb = lds + (t & 1) * KBUF; const lchar* Vb = lds + OFFV + (t & 1) * VBUF;
        f32x4 s[QG][4];
#pragma unroll
        for (int g = 0; g < QG; ++g)
#pragma unroll
            for (int kb = 0; kb < 4; ++kb) s[g][kb] = (f32x4){0.f, 0.f, 0.f, 0.f};
#pragma unroll
        for (int kb = 0; kb < 4; ++kb)
#pragma unroll
            for (int ks = 0; ks < NKS; ++ks) {
                const bf16x8 kf = *(const LAS bf16x8*)(Kb + (kb * 16 + fr) * KS + ks * 64 + fq * 16);
#pragma unroll
                for (int g = 0; g < QG; ++g) s[g][kb] = __builtin_amdgcn_mfma_f32_16x16x32_bf16(kf, qf[g][ks], s[g][kb], 0, 0, 0);
            }
        if (t >= 4) {
            if (MODE == 2) {
                const int k0t = lat0 + (t - 4) * 64;
#pragma unroll
                for (int g = 0; g < QG; ++g) { const int qpos = qi * 128 + wid * 32 + g * 16 + fr;
#pragma unroll
                    for (int kb = 0; kb < 4; ++kb)
#pragma unroll
                        for (int j = 0; j < 4; ++j) { const int d = qpos - (k0t + kb * 16 + fq * 4 + j); if (d > 128 || d < -128) s[g][kb][j] = -1e30f; } }
            }
            if (MODE == 3) {
                const int c = wid * 16 + fr, cs = min(max(c - 8, 0), 48), krow = rs + (t - 4);
                const int brow = (krow - qi + 7) * 31;
#pragma unroll
                for (int kb = 0; kb < 4; ++kb)
#pragma unroll
                    for (int j = 0; j < 4; ++j) { const int kc = kb * 16 + fq * 4 + j; const bool ok = (unsigned)(kc - cs) < 16u;
                        const float bv = btab[ok ? brow + kc - c + 15 : 0];
                        s[0][kb][j] = ok ? s[0][kb][j] + bv : -1e30f; }
            }
        }
        bf16x8 pf[QG][2];
#pragma unroll
        for (int g = 0; g < QG; ++g) {
            float mx = s[g][0][0];
#pragma unroll
            for (int kb = 0; kb < 4; ++kb)
#pragma unroll
                for (int j = 0; j < 4; ++j) mx = fmaxf(mx, s[g][kb][j]);
            mx = fmaxf(mx, __shfl_xor(mx, 16)); mx = fmaxf(mx, __shfl_xor(mx, 32));
            const float mnew = fmaxf(mrun[g], mx), alpha = fexp2(mrun[g] - mnew);
            mrun[g] = mnew;
            float ls = 0.f;
#pragma unroll
            for (int kb = 0; kb < 4; ++kb)
#pragma unroll
                for (int j = 0; j < 4; ++j) { const float e = fexp2(s[g][kb][j] - mnew); s[g][kb][j] = e; ls += e; }
            lrun[g] = lrun[g] * alpha + ls;
#pragma unroll
            for (int d = 0; d < 4; ++d) o[g][d] *= alpha;
#pragma unroll
            for (int kk = 0; kk < 2; ++kk) {
                const unsigned w0 = pk2(s[g][2 * kk][0], s[g][2 * kk][1]), w1 = pk2(s[g][2 * kk][2], s[g][2 * kk][3]);
                const unsigned w2 = pk2(s[g][2 * kk + 1][0], s[g][2 * kk + 1][1]), w3 = pk2(s[g][2 * kk + 1][2], s[g][2 * kk + 1][3]);
                const u32x4 w = {w0, w1, w2, w3};
                pf[g][kk] = __builtin_bit_cast(bf16x8, w);
            }
        }
#pragma unroll
        for (int db = 0; db < 4; ++db)
#pragma unroll
            for (int kk = 0; kk < 2; ++kk) {
                const lchar* va = Vb + (kk * 32 + 4 * fq + (fr >> 2)) * VS + db * 32 + (fr & 3) * 8;
                const v4i16 v0 = __builtin_amdgcn_ds_read_tr16_b64_v4i16((LAS v4i16*)va);
                const v4i16 v1 = __builtin_amdgcn_ds_read_tr16_b64_v4i16((LAS v4i16*)(va + 16 * VS));
                const bf16x8 vf = __builtin_shufflevector(v0, v1, 0, 1, 2, 3, 4, 5, 6, 7);
#pragma unroll
                for (int g = 0; g < QG; ++g) o[g][db] = __builtin_amdgcn_mfma_f32_16x16x32_bf16(vf, pf[g][kk], o[g][db], 0, 0, 0);
            }
        if (t + 1 < ntile) write_tile((t + 1) & 1);
        __syncthreads();
    }
    bf16_t* O = (bf16_t*)(p.ws + OFF_MIXIN);
#pragma unroll
    for (int g = 0; g < QG; ++g) {
        float lt = lrun[g]; lt += __shfl_xor(lt, 16); lt += __shfl_xor(lt, 32);
        const float inv = 1.f / lt;
        const size_t row = (size_t)(qrow0 + g * 16 + fr);
#pragma unroll
        for (int d = 0; d < 4; ++d) {
            u32x2 v = {pk2(o[g][d][0] * inv, o[g][d][1] * inv), pk2(o[g][d][2] * inv, o[g][d][3] * inv)};
            *(u32x2*)(O + row * 1024 + ocol + d * 16 + fq * 4) = v;
        }
    }
}

DEVI void phase_s4(lchar* lds, const Params& p, int l) {
    const int G = gridDim.x, bid = blockIdx.x;
    const int nc3 = l == 0 ? 64 : 0, nc4 = l == 0 ? 128 : 0;
    for (int u = bid; u < 512 + nc3; u += G) { const bool cq = u >= 512; const int v = cq ? u - 512 : u; attn_unit<0>(lds, p, l, v & 7, (v >> 3) & 3, v >> 5, cq); }
    for (int u = bid; u < 512 + nc3; u += G) { const bool cq = u >= 512; const int v = cq ? u - 512 : u; attn_unit<1>(lds, p, l, v & 7, (v >> 3) & 3, v >> 5, cq); }
    for (int u = bid; u < 512 + nc3; u += G) { const bool cq = u >= 512; const int v = cq ? u - 512 : u; attn_unit<2>(lds, p, l, v & 7, (v >> 3) & 3, v >> 5, cq); }
    for (int u = bid; u < 1024 + nc4; u += G) { const bool cq = u >= 1024; const int v = cq ? u - 1024 : u; attn_unit<3>(lds, p, l, v & 7, (v >> 3) & 3, v >> 5, cq); }
}

DEVI float gmax8(float v) { v = fmaxf(v, __shfl_xor(v, 1)); v = fmaxf(v, __shfl_xor(v, 2)); v = fmaxf(v, __shfl_xor(v, 4)); return v; }
DEVI void phase_s6(lchar* lds, const Params& p, int l) {
    const int tid = ltid(), wid = tid >> 6, lane = tid & 63, G = gridDim.x;
    const int ntile = (l == 0 ? T_ALL : T_LAT) / RT_TILE;
    LAS float* ht = (LAS float*)lds;
    LAS int* tot = (LAS int*)(lds + 65536);
    const bf16_t* MIX = (const bf16_t*)(p.ws + OFF_MIX);
    bf16_t* H = (bf16_t*)(p.ws + OFF_H);
    const float* pg = p.post_mix_g + l * 1024; const float* fg = p.pre_ffn_g + l * 1024;
    unsigned char* e8 = (unsigned char*)(p.ws + OFF_E8); float* w8 = (float*)(p.ws + OFF_W8); unsigned short* lr8 = (unsigned short*)(p.ws + OFF_LR8);
    int* hist = (int*)(p.ws + OFF_HIST);
    const float rbias = p.router_b[l * 64 + lane];
    const float* rw = p.router_w + (size_t)l * 1024 * 64 + lane;
    for (int tile = blockIdx.x; tile < ntile; tile += G) {
        for (int rr = 0; rr < 4; ++rr) {
            const int r = tile * RT_TILE + wid * 4 + rr;
            const int bb = r < T_LAT ? (r >> 11) : 8;
            const float* mod = (const float*)(p.ws + OFF_MOD) + ((size_t)l * 9 + bb) * 6144;
            const float* xr = xrow_ptr(p, l, r);
            float* xo = r < T_LAT ? p.out + (size_t)r * 1024 : (float*)(p.ws + OFF_XC) + (size_t)(r - T_LAT) * 1024;
            float mv[16]; float ss = 0.f;
#pragma unroll
            for (int i = 0; i < 4; ++i) { const u32x2 u = *(const u32x2*)(MIX + (size_t)r * 1024 + i * 256 + lane * 4);
                mv[i * 4 + 0] = bflo(u[0]); mv[i * 4 + 1] = bfhi(u[0]); mv[i * 4 + 2] = bflo(u[1]); mv[i * 4 + 3] = bfhi(u[1]); }
#pragma unroll
            for (int i = 0; i < 16; ++i) ss += mv[i] * mv[i];
            ss = wave_sum(ss);
            const float rs1 = rsqrtf(ss * (1.f / 1024.f) + EPS);
            float x1[16]; float s2 = 0.f;
#pragma unroll
            for (int i = 0; i < 4; ++i) {
                const int c = i * 256 + lane * 4;
                const float4 xv = *(const float4*)(xr + c), gg = *(const float4*)(pg + c), g1 = *(const float4*)(mod + 2048 + c);
                x1[i * 4 + 0] = xv.x + g1.x * (mv[i * 4 + 0] * rs1 * gg.x); x1[i * 4 + 1] = xv.y + g1.y * (mv[i * 4 + 1] * rs1 * gg.y);
                x1[i * 4 + 2] = xv.z + g1.z * (mv[i * 4 + 2] * rs1 * gg.z); x1[i * 4 + 3] = xv.w + g1.w * (mv[i * 4 + 3] * rs1 * gg.w);
                *(float4*)(xo + c) = make_float4(x1[i * 4 + 0], x1[i * 4 + 1], x1[i * 4 + 2], x1[i * 4 + 3]);
            }
#pragma unroll
            for (int i = 0; i < 16; ++i) s2 += x1[i] * x1[i];
            s2 = wave_sum(s2);
            const float rs2 = rsqrtf(s2 * (1.f / 1024.f) + EPS);
#pragma unroll
            for (int i = 0; i < 4; ++i) {
                const int c = i * 256 + lane * 4;
                const float4 gg = *(const float4*)(fg + c), sh = *(const float4*)(mod + 3072 + c), sc = *(const float4*)(mod + 4096 + c);
                const float a0 = x1[i * 4 + 0] * rs2 * gg.x * (1.f + sc.x) + sh.x, a1 = x1[i * 4 + 1] * rs2 * gg.y * (1.f + sc.y) + sh.y;
                const float a2 = x1[i * 4 + 2] * rs2 * gg.z * (1.f + sc.z) + sh.z, a3 = x1[i * 4 + 3] * rs2 * gg.w * (1.f + sc.w) + sh.w;
                *(u32x2*)(H + (size_t)r * 1024 + c) = (u32x2){pk2(a0, a1), pk2(a2, a3)};
                *(LAS f32x4*)(ht + (wid * 4 + rr) * 1024 + c) = (f32x4){a0, a1, a2, a3};
            }
        }
        __syncthreads();
        float acc[4] = {0.f, 0.f, 0.f, 0.f};
        for (int k = 0; k < 1024; k += 4) {
            const float w0 = rw[(size_t)(k + 0) * 64], w1 = rw[(size_t)(k + 1) * 64], w2 = rw[(size_t)(k + 2) * 64], w3 = rw[(size_t)(k + 3) * 64];
#pragma unroll
            for (int t = 0; t < 4; ++t) { const f32x4 hv = *(const LAS f32x4*)(ht + (wid * 4 + t) * 1024 + k);
                acc[t] = fmaf(hv[0], w0, acc[t]); acc[t] = fmaf(hv[1], w1, acc[t]); acc[t] = fmaf(hv[2], w2, acc[t]); acc[t] = fmaf(hv[3], w3, acc[t]); }
        }
        int cntw = 0; bool sel[4]; int jj[4], lrw[4]; float ww[4];
#pragma unroll
        for (int t = 0; t < 4; ++t) {
            const float sg = 1.f / (1.f + expf(-acc[t])), sb = sg + rbias;
            const float m1 = gmax8(sb);
            const unsigned long long eqm = __ballot(sb == m1);
            const int gbase = lane & ~7;
            const unsigned gm = (unsigned)(eqm >> gbase) & 0xffu;
            const int am = gbase + __ffs(gm) - 1;
            const float m2 = gmax8(lane == am ? -INFINITY : sb);
            const float gs = m1 + m2;
            const int myg = lane >> 3; int grank = 0;
#pragma unroll
            for (int g2 = 0; g2 < 8; ++g2) { const float ov = __shfl(gs, g2 * 8); grank += (ov > gs || (ov == gs && g2 < myg)) ? 1 : 0; }
            const bool gsel = grank < 4;
            const float v = gsel ? sb : -INFINITY;
            int rank = 0;
#pragma unroll 8
            for (int j = 0; j < 64; ++j) { const float ov = __shfl(v, j); rank += (ov > v || (ov == v && j < lane)) ? 1 : 0; }
            sel[t] = gsel && rank < 8;
            const float wsum = wave_sum(sel[t] ? sg : 0.f);
            const unsigned long long sm = __ballot(sel[t]);
            jj[t] = __popcll(sm & ((1ull << lane) - 1ull));
            ww[t] = sg / wsum * 2.5f;
            lrw[t] = cntw; cntw += sel[t] ? 1 : 0;
        }
        tot[wid * 64 + lane] = cntw;
        __syncthreads();
        int base = 0, total = 0;
#pragma unroll
        for (int w = 0; w < 4; ++w) { const int c = tot[w * 64 + lane]; base += w < wid ? c : 0; total += c; }
        if (wid == 0) hist[tile * 64 + lane] = total;
#pragma unroll
        for (int t = 0; t < 4; ++t) if (sel[t]) {
            const size_t idx = (size_t)(tile * RT_TILE + wid * 4 + t) * 8 + jj[t];
            e8[idx] = (unsigned char)lane; w8[idx] = ww[t]; lr8[idx] = (unsigned short)(base + lrw[t]);
        }
        __syncthreads();
    }
}

DEVI void phase_s7(const Params& p, int l) {
    const int wid = ltid() >> 6, lane = ltid() & 63, gw = blockIdx.x * 4 + wid;
    if (gw >= 64) return;
    const int ntile = (l == 0 ? T_ALL : T_LAT) / RT_TILE, per = (ntile + 63) / 64, e = gw;
    const int* hist = (const int*)(p.ws + OFF_HIST); int* toff = (int*)(p.ws + OFF_TOFF); int* cnt = (int*)(p.ws + OFF_CNT);
    int sum = 0;
    for (int i = 0; i < per; ++i) { const int tt = lane * per + i; if (tt < ntile) sum += hist[tt * 64 + e]; }
    int inc = sum;
#pragma unroll
    for (int o = 1; o < 64; o <<= 1) { const int t = __shfl_up(inc, o); if (lane >= o) inc += t; }
    int run = inc - sum;
    for (int i = 0; i < per; ++i) { const int tt = lane * per + i; if (tt < ntile) { toff[tt * 64 + e] = run; run += hist[tt * 64 + e]; } }
    if (lane == 63) cnt[e] = inc;
}

DEVI void phase_s8(lchar* lds, const Params& p, int l) {
    build_seg(lds, p);
    LAS int* seg = (LAS int*)(lds + 66048);
    const int ntok = l == 0 ? T_ALL : T_LAT, n = ntok * 8;
    const unsigned char* e8 = (const unsigned char*)(p.ws + OFF_E8); const unsigned short* lr8 = (const unsigned short*)(p.ws + OFF_LR8);
    const int* toff = (const int*)(p.ws + OFF_TOFF); const int* cnt = (const int*)(p.ws + OFF_CNT);
    int* stk = (int*)(p.ws + OFF_STK); int* tsl = (int*)(p.ws + OFF_TSL);
    for (int i = blockIdx.x * 256 + ltid(); i < n; i += gridDim.x * 256) {
        const int t = i >> 3, e = e8[i];
        const int slot = seg[e] + toff[(t >> 4) * 64 + e] + lr8[i];
        stk[slot] = t; tsl[i] = slot;
    }
    for (int e = blockIdx.x; e < 64; e += gridDim.x) { const int s0 = seg[e] + cnt[e], s1 = seg[e + 1]; for (int s = s0 + ltid(); s < s1; s += 256) stk[s] = 0; }
}

DEVI void phase_s11(const Params& p, int l) {
    const int wid = ltid() >> 6, lane = ltid() & 63, gw = blockIdx.x * 4 + wid, nw = gridDim.x * 4;
    const int ntok = l == 0 ? T_ALL : T_LAT;
    const int* tsl = (const int*)(p.ws + OFF_TSL); const float* w8 = (const float*)(p.ws + OFF_W8);
    const bf16_t* Y = (const bf16_t*)(p.ws + OFF_Y); const bf16_t* YS = (const bf16_t*)(p.ws + OFF_H);
    const float* pg = p.post_ffn_g + l * 1024;
    for (int t = gw; t < ntok; t += nw) {
        const int slot = tsl[(size_t)t * 8 + (lane & 7)]; const float wv = w8[(size_t)t * 8 + (lane & 7)];
        float f[16];
#pragma unroll
        for (int i = 0; i < 16; ++i) f[i] = 0.f;
#pragma unroll
        for (int j = 0; j < 8; ++j) {
            const int sj = __shfl(slot, j); const float wj = __shfl(wv, j);
            const bf16_t* row = Y + (size_t)sj * 1024;
#pragma unroll
            for (int i = 0; i < 2; ++i) { const u32x4 v = *(const u32x4*)(row + (lane + 64 * i) * 8);
#pragma unroll
                for (int q = 0; q < 4; ++q) { f[i * 8 + 2 * q] += wj * bflo(v[q]); f[i * 8 + 2 * q + 1] += wj * bfhi(v[q]); } }
        }
        {
            const bf16_t* row = YS + (size_t)t * 1024;
#pragma unroll
            for (int i = 0; i < 2; ++i) { const u32x4 v = *(const u32x4*)(row + (lane + 64 * i) * 8);
#pragma unroll
                for (int q = 0; q < 4; ++q) { f[i * 8 + 2 * q] += bflo(v[q]); f[i * 8 + 2 * q + 1] += bfhi(v[q]); } }
        }
        float ss = 0.f;
#pragma unroll
        for (int i = 0; i < 16; ++i) ss += f[i] * f[i];
        ss = wave_sum(ss);
        const float rs = rsqrtf(ss * (1.f / 1024.f) + EPS);
        const int bb = t < T_LAT ? (t >> 11) : 8;
        const float* g2 = (const float*)(p.ws + OFF_MOD) + ((size_t)l * 9 + bb) * 6144 + 5120;
        float* xo = t < T_LAT ? p.out + (size_t)t * 1024 : (float*)(p.ws + OFF_XC) + (size_t)(t - T_LAT) * 1024;
#pragma unroll
        for (int i = 0; i < 2; ++i)
#pragma unroll
            for (int hq = 0; hq < 2; ++hq) {
                const int c = (lane + 64 * i) * 8 + hq * 4;
                const float4 xv = *(const float4*)(xo + c), gg = *(const float4*)(pg + c), gv = *(const float4*)(g2 + c);
                float4 r;
                r.x = xv.x + gv.x * (f[i * 8 + hq * 4 + 0] * rs * gg.x); r.y = xv.y + gv.y * (f[i * 8 + hq * 4 + 1] * rs * gg.y);
                r.z = xv.z + gv.z * (f[i * 8 + hq * 4 + 2] * rs * gg.z); r.w = xv.w + gv.w * (f[i * 8 + hq * 4 + 3] * rs * gg.w);
                *(float4*)(xo + c) = r;
            }
    }
}

constexpr int N_PHASES = 1 + 2 * 11;
__global__ void __launch_bounds__(256, 2) mega(Params p) {
    extern __shared__ __attribute__((aligned(16))) char smem[];
    lchar* lds = (lchar*)smem;
    const int G = gridDim.x, bid = blockIdx.x;
    const bool multi = p.ph_hi - p.ph_lo > 1;
    XcdBarrier bar;
    if (multi) {
        volatile LAS unsigned* xbw = (volatile LAS unsigned*)(lds + LDS_XB);
        if (threadIdx.x == 0) { xbw[0] = 0u; xbw[1] = 0u; xbw[2] = 0u; xbw[3] = 0u; }
        __syncthreads();
        bar = xcd_barrier_post((unsigned*)(p.ws + OFF_CTL), xbw);
    }
#ifndef AUDIT_MASK
#define AUDIT_MASK 0xfff
#endif
#define EN(j) (((AUDIT_MASK) >> (j)) & 1)
#define PH(k) (p.ph_lo <= (k) && (k) < p.ph_hi)
#define SEAM(k) do { if (p.ph_lo <= (k) && (k) + 1 < p.ph_hi) xcd_barrier(bar); } while (0)
    if (EN(0) && PH(0)) phase_s0(lds, p);
    SEAM(0);
    for (int l = 0; l < 2; ++l) {
        const int pb = 1 + l * 11;
        const int nmt_all = l == 0 ? T_ALL / 128 : T_LAT / 128;
        if (EN(1) && PH(pb + 0)) { phase_s1(p, l); if (l == 1) for (int t = bid; t < CT_EXP; t += G) conv_exp_tile(lds, p, 1, t); }
        SEAM(pb + 0);
        if (EN(2) && PH(pb + 1)) for (int u = bid; u < (T_ALL / 128) * 19; u += G) inproj_unit(lds, p, l, u / 19, u % 19);
        SEAM(pb + 1);
        if (EN(3) && PH(pb + 2)) for (int u = bid; u < (T_ALL / 128) * 4; u += G) kvup_unit(lds, p, l, u >> 2, u & 3);
        SEAM(pb + 2);
        if (EN(4) && PH(pb + 3)) phase_s4(lds, p, l);
        SEAM(pb + 3);
        if (EN(5) && PH(pb + 4)) for (int u = bid; u < nmt_all * 8; u += G) outproj_unit(lds, p, l, u >> 3, u & 7);
        SEAM(pb + 4);
        if (EN(6) && PH(pb + 5)) phase_s6(lds, p, l);
        SEAM(pb + 5);
        if (EN(7) && PH(pb + 6)) phase_s7(p, l);
        SEAM(pb + 6);
        if (EN(8) && PH(pb + 7)) phase_s8(lds, p, l);
        SEAM(pb + 7);
        if (EN(9) && PH(pb + 8)) { build_seg(lds, p); const int nmt_r = ((LAS int*)(lds + 66048))[64] >> 7; for (int u = bid; u < (nmt_r + nmt_all) * 4; u += G) gateup_unit(lds, p, u >> 2, u & 3, nmt_r); }
        SEAM(pb + 8);
        if (EN(10) && PH(pb + 9)) { build_seg(lds, p); const int nmt_r = ((LAS int*)(lds + 66048))[64] >> 7; for (int u = bid; u < (nmt_r + nmt_all) * 8; u += G) down_unit(lds, p, u >> 3, u & 7, nmt_r); }
        SEAM(pb + 9);
        if (EN(11) && PH(pb + 10)) phase_s11(p, l);
        SEAM(pb + 10);
    }
}

extern "C" void kernel_launch(void* const* d_in, const int* in_sizes, int n_in, void* d_out, int out_size, void* d_ws, size_t ws_size, hipStream_t stream) {
    if (n_in < 26 || ws_size < WS_NEED) { fprintf(stderr, "kernel_launch: bad arguments (n_in %d, ws %zu < %zu)\n", n_in, ws_size, (size_t)WS_NEED); return; }
    Params p{};
    const float** pp = (const float**)&p;
    for (int i = 0; i < 26; ++i) pp[i] = (const float*)d_in[i];
    p.out = (float*)d_out; p.ws = (char*)d_ws;
    static int grid = 0;
    if (!grid) {
        int dev = 0, cus = 0, per_cu = 0;
        (void)hipGetDevice(&dev);
        (void)hipDeviceGetAttribute(&cus, hipDeviceAttributeMultiprocessorCount, dev);
        (void)hipFuncSetAttribute((const void*)mega, hipFuncAttributeMaxDynamicSharedMemorySize, LDS_BYTES);
        (void)hipOccupancyMaxActiveBlocksPerMultiprocessor(&per_cu, mega, 256, LDS_BYTES);
        if (per_cu < 1) per_cu = 1;
        grid = cus * (per_cu < 2 ? per_cu : 2);
    }
    (void)hipMemsetAsync((char*)d_ws + OFF_CTL, 0, CTL_BYTES, stream);
#if ONE_LAUNCH
    p.ph_lo = 0; p.ph_hi = N_PHASES;
    hipLaunchKernelGGL(mega, dim3(grid), dim3(256), LDS_BYTES, stream, p);
#else
    for (int k = 0; k < N_PHASES; ++k) { p.ph_lo = k; p.ph_hi = k + 1; hipLaunchKernelGGL(mega, dim3(grid), dim3(256), LDS_BYTES, stream, p); }
#endif
}
```

```cpp
#include <hip/hip_runtime.h>
#include <stdint.h>
#include <stdio.h>
#include <string.h>
#include <type_traits>

#ifndef ONE_LAUNCH
#define ONE_LAUNCH 1
#endif

#ifndef Y8_ALL
#define Y8_ALL 1
#endif
#define DEVI __device__ __forceinline__
#define LAS __attribute__((address_space(3)))

typedef unsigned short bf16_t;
typedef short bf16x8 __attribute__((ext_vector_type(8)));
typedef short s16x4 __attribute__((ext_vector_type(4)));
typedef float f32x4 __attribute__((ext_vector_type(4)));
typedef float f32x2 __attribute__((ext_vector_type(2)));
typedef __bf16 bf16x2_t __attribute__((ext_vector_type(2)));
typedef unsigned u32x4 __attribute__((ext_vector_type(4)));
typedef unsigned u32x2 __attribute__((ext_vector_type(2)));
typedef LAS char lchar;

constexpr int DM = 1024, BATCH = 8, SEQ = 2048, CTXL = 256, DEPTH = 2;
constexpr int T_LAT = BATCH * SEQ, T_CTX = BATCH * CTXL, T_ALL = T_LAT + T_CTX;
constexpr int IN_W = 2336, NP = 2560, NKV = 512;
constexpr int NEXP = 64, EDIM = 256;
constexpr float EPS = 1e-6f;
constexpr float LOG2E = 1.4426950408889634f;
constexpr int PC_AQ = 0, PC_AK = 256, PC_AV = 384, PC_BQN = 512, PC_BQR = 768, PC_CKV = 896, PC_CQ = 1024, PC_CK = 1280, PC_CV = 1408,
              PC_DQ = 1536, PC_DK = 1792, PC_DV = 2048, PC_BKR = 2304;
constexpr int RSLOTS = 147456 + 64 * 256;
constexpr int SH_BASE = RSLOTS;
constexpr int ACT_ROWS = RSLOTS + T_ALL;
constexpr int NT = 512, NW = NT / 64;
constexpr int RT_TILE = 16;
constexpr int MAX_RT = T_ALL / RT_TILE;

constexpr size_t al256(size_t x) { return (x + 255) & ~(size_t)255; }
constexpr size_t OFF_CTL = 0, CTL_BYTES = 65536;
constexpr size_t OFF_MOD = OFF_CTL + CTL_BYTES;
constexpr size_t OFF_TABH = al256(OFF_MOD + (size_t)2 * 9 * 6144 * 4);
constexpr size_t OFF_TABR = al256(OFF_TABH + (size_t)2048 * 32 * 8);
constexpr size_t OFF_WIN = al256(OFF_TABR + (size_t)2048 * 16 * 8);
constexpr size_t OFF_WOUT = al256(OFF_WIN + (size_t)2 * NP * 1024 * 2);
constexpr size_t OFF_WKV = al256(OFF_WOUT + (size_t)2 * 1024 * 1024 * 2);
constexpr size_t OFF_XC = al256(OFF_WKV + (size_t)2 * 512 * 128 * 2);
constexpr size_t OFF_E8 = al256(OFF_XC + (size_t)T_CTX * 1024 * 4);
constexpr size_t OFF_W8 = al256(OFF_E8 + (size_t)T_ALL * 8);
constexpr size_t OFF_LR8 = al256(OFF_W8 + (size_t)T_ALL * 8 * 4);
constexpr size_t OFF_TSL = al256(OFF_LR8 + (size_t)T_ALL * 8 * 2);
constexpr size_t OFF_STK = al256(OFF_TSL + (size_t)T_ALL * 8 * 4);
constexpr size_t OFF_HIST = al256(OFF_STK + (size_t)RSLOTS * 4);
constexpr size_t OFF_TOFF = al256(OFF_HIST + (size_t)MAX_RT * 64 * 4);
constexpr size_t OFF_CNT = al256(OFF_TOFF + (size_t)MAX_RT * 64 * 4);
constexpr size_t OFF_WRT = al256(OFF_CNT + 256);
constexpr size_t OFF_GOFF = al256(OFF_WRT + (size_t)2 * 64 * 1024 * 4);
constexpr size_t OFF_WD = al256(OFF_GOFF + (size_t)256 * 8 * 512 * 16);
constexpr size_t OFF_H = al256(OFF_WD + (size_t)65 * 1024 * 256 * 2);
constexpr size_t OFF_ACT = al256(OFF_H + (size_t)T_ALL * 1024 * 2);
constexpr size_t OFF_WGU = al256(OFF_ACT + (size_t)ACT_ROWS * 256 * 2);
constexpr size_t OFF_Y = OFF_WGU;
constexpr size_t OFF_P = al256(OFF_WGU + (size_t)65 * 512 * 1024 * 2);
constexpr size_t OFF_KVB = al256(OFF_P + (size_t)T_ALL * NP * 2);
constexpr size_t OFF_MIXIN = al256(OFF_KVB + (size_t)T_ALL * NKV * 2);
constexpr size_t OFF_MIX = al256(OFF_MIXIN + (size_t)T_ALL * 1024 * 2);
constexpr size_t ATT_END = al256(OFF_MIX + (size_t)T_ALL * 1024 * 2);
constexpr size_t Y_END = al256(OFF_Y + (size_t)RSLOTS * 1024 * (Y8_ALL ? 1 : 2));
constexpr size_t OFF_XB = (ATT_END > Y_END ? ATT_END : Y_END);
constexpr size_t WS_NEED = al256(OFF_XB + (size_t)T_ALL * 1024 * 2);

constexpr int LDS_BYTES = 159888;
constexpr int GOFF_LDS = 139264;
constexpr int RSV_OFF = 131584, SEG_OFF = 132608;
constexpr int LDS_XB = LDS_BYTES - 16;

struct Params {
    const float *x, *c, *ctx, *c_ctx, *ada_w, *ada_b, *pre_mix_g, *post_mix_g, *pre_ffn_g, *post_ffn_g, *w_in, *a_q_norm, *a_k_norm,
        *b_kv_norm, *b_w_kv_up, *c_sink, *d_rpb, *w_out, *router_w, *router_b, *exp_w_gate, *exp_w_up, *exp_w_down, *sh_w_gate, *sh_w_up, *sh_w_down;
    float* out; char* ws; int ph_lo, ph_hi;
};

DEVI unsigned pk2(float lo, float hi) { f32x2 v = {lo, hi}; bf16x2_t b = __builtin_convertvector(v, bf16x2_t); return __builtin_bit_cast(unsigned, b); }
DEVI float bflo(unsigned u) { return __uint_as_float(u << 16); }
DEVI float bfhi(unsigned u) { return __uint_as_float(u & 0xffff0000u); }
template <int CTRL> DEVI float dpp_f(float v) { return __int_as_float(__builtin_amdgcn_update_dpp(0, __float_as_int(v), CTRL, 0xf, 0xf, false)); }
DEVI float gmax8(float v) { v = fmaxf(v, dpp_f<0xB1>(v)); v = fmaxf(v, dpp_f<0x4E>(v)); v = fmaxf(v, dpp_f<0x141>(v)); return v; }
DEVI float wave_max_dpp(float v) {
    v = fmaxf(v, dpp_f<0xB1>(v)); v = fmaxf(v, dpp_f<0x4E>(v)); v = fmaxf(v, dpp_f<0x141>(v)); v = fmaxf(v, dpp_f<0x140>(v));
    const int iv = __float_as_int(v);
    const float a = __int_as_float(__builtin_amdgcn_readlane(iv, 0)), b = __int_as_float(__builtin_amdgcn_readlane(iv, 16));
    const float c = __int_as_float(__builtin_amdgcn_readlane(iv, 32)), d = __int_as_float(__builtin_amdgcn_readlane(iv, 48));
    return fmaxf(fmaxf(a, b), fmaxf(c, d));
}
DEVI float wave_sum_dpp(float v) {
    v += dpp_f<0xB1>(v); v += dpp_f<0x4E>(v); v += dpp_f<0x141>(v); v += dpp_f<0x140>(v);
    const int iv = __float_as_int(v);
    const float a = __int_as_float(__builtin_amdgcn_readlane(iv, 0)), b = __int_as_float(__builtin_amdgcn_readlane(iv, 16));
    const float c = __int_as_float(__builtin_amdgcn_readlane(iv, 32)), d = __int_as_float(__builtin_amdgcn_readlane(iv, 48));
    return (a + b) + (c + d);
}
DEVI float wave_sum(float v) { return wave_sum_dpp(v); }

DEVI int ltid() { int t = threadIdx.x; asm volatile("" : "+v"(t)); return t; }
DEVI int vtid() { return ltid() & 255; }
DEVI float rows_max(float v) {
    { const auto r = __builtin_amdgcn_permlane16_swap(__float_as_uint(v), __float_as_uint(v), false, false); v = fmaxf(__uint_as_float(r[0]), __uint_as_float(r[1])); }
    { const auto r = __builtin_amdgcn_permlane32_swap(__float_as_uint(v), __float_as_uint(v), false, false); v = fmaxf(__uint_as_float(r[0]), __uint_as_float(r[1])); }
    return v;
}
DEVI float rows_sum(float v) {
    { const auto r = __builtin_amdgcn_permlane16_swap(__float_as_uint(v), __float_as_uint(v), false, false); v = __uint_as_float(r[0]) + __uint_as_float(r[1]); }
    { const auto r = __builtin_amdgcn_permlane32_swap(__float_as_uint(v), __float_as_uint(v), false, false); v = __uint_as_float(r[0]) + __uint_as_float(r[1]); }
    return v;
}
DEVI float fexp2(float x) { return __builtin_amdgcn_exp2f(x); }
DEVI float silu_f(float x) { return x * __builtin_amdgcn_rcpf(1.f + __builtin_amdgcn_exp2f(-LOG2E * x)); }

#define XB_TMO      128
#define XB_XCNT(j)  (256  + 64 * (j))
#define XB_XSUB(j)  (1280 + 64 * (j))
#define XB_XGEN(j)  (2304 + 64 * (j))
#define XB_TOP      3328
#define XB_TOPGEN   3392
#define XCD_BAR_WORDS 3456
#define XB_SPIN_CAP (1u << 18)

DEVI unsigned xb_ld(unsigned* p)              { return __hip_atomic_load(p, __ATOMIC_RELAXED, __HIP_MEMORY_SCOPE_AGENT); }
DEVI unsigned xb_add(unsigned* p, unsigned v) { return __hip_atomic_fetch_add(p, v, __ATOMIC_RELAXED, __HIP_MEMORY_SCOPE_AGENT); }
DEVI unsigned xb_xcc_id() { return (unsigned)__builtin_amdgcn_s_getreg((3 << 11) | 20) & 0xFu; }
#define XB_SPIN(cond, bar) do { unsigned _sp = 0; while (cond) { __builtin_amdgcn_s_sleep(1); \
    if ((++_sp & 255u) == 0u) { if (xb_ld(&(bar)[XB_TMO])) break; if (_sp > XB_SPIN_CAP) { atomicAdd(&(bar)[XB_TMO], 1u); break; } } } } while (0)

struct XcdBarrier { unsigned* bar; unsigned x; volatile LAS unsigned* st; };

DEVI XcdBarrier xcd_barrier_post(unsigned* bar, volatile LAS unsigned* st) {
    XcdBarrier b; b.bar = bar; b.x = xb_xcc_id(); b.st = st;
    if (threadIdx.x == 0) (void)xb_add(&bar[XB_XCNT(b.x)], 1u);
    return b;
}
DEVI void xcd_barrier_complete(unsigned* bar, unsigned x, unsigned& nloc, unsigned& nx) {
    const unsigned G = gridDim.x * gridDim.y * gridDim.z;
    unsigned sum, cnt, mine, sp = 0u;
    for (;;) {
        sum = 0u; cnt = 0u; mine = 0u;
#pragma unroll
        for (unsigned j = 0; j < 16; ++j) { const unsigned c = xb_ld(&bar[XB_XCNT(j)]); sum += c; cnt += (c > 0u) ? 1u : 0u; mine = (j == x) ? c : mine; }
        if (sum == G) break;
        __builtin_amdgcn_s_sleep(1);
        if ((++sp & 255u) == 0u) { if (xb_ld(&bar[XB_TMO])) break; if (sp > XB_SPIN_CAP) { atomicAdd(&bar[XB_TMO], 1u); break; } }
    }
    nloc = mine > 0u ? mine : 1u; nx = cnt > 0u ? cnt : 1u;
}
DEVI void xcd_barrier(const XcdBarrier& b) {
    asm volatile("s_waitcnt vmcnt(0)" ::: "memory");
    __syncthreads();
    if (threadIdx.x == 0) {
        unsigned* bar = b.bar;
        __builtin_amdgcn_s_waitcnt(0);
        unsigned nloc = b.st[0], nx = b.st[1];
        if (nloc == 0u) { xcd_barrier_complete(bar, b.x, nloc, nx); b.st[0] = nloc; b.st[1] = nx; }
        const unsigned old = xb_add(&bar[XB_XSUB(b.x)], 1u);
        const unsigned gen = old / nloc;
        if (old + 1u == (gen + 1u) * nloc) {
            __builtin_amdgcn_fence(__ATOMIC_RELEASE, "agent");
            asm volatile("s_waitcnt vmcnt(0)" ::: "memory");
            const unsigned og = xb_add(&bar[XB_TOP], 1u);
            const unsigned tg = og / nx;
            if (og + 1u == (tg + 1u) * nx) xb_add(&bar[XB_TOPGEN], 1u);
            else XB_SPIN(xb_ld(&bar[XB_TOPGEN]) == tg, bar);
            __builtin_amdgcn_fence(__ATOMIC_ACQUIRE, "agent");
            xb_add(&bar[XB_XGEN(b.x)], 1u);
            asm volatile("s_waitcnt vmcnt(0)" ::: "memory");
        } else {
            XB_SPIN(xb_ld(&bar[XB_XGEN(b.x)]) == gen, bar);
            __builtin_amdgcn_fence(__ATOMIC_ACQUIRE, "agent");
            asm volatile("s_waitcnt vmcnt(0)" ::: "memory");
        }
    }
    __syncthreads();
}

DEVI int lds_byte(int r, int c) { const int st = (r >> 4) * 2 + (c >> 5), rr = r & 15, cc = c & 31, ob = rr * 64 + cc * 2; return st * 1024 + (ob ^ (((ob >> 9) & 1) << 5)); }
DEVI void stage_rc(int b, int& R, int& C) { const int st = b / 1024, sb = b % 1024, swz = sb ^ (((sb >> 9) & 1) << 5); R = (st >> 1) * 16 + swz / 64; C = (st & 1) * 32 + (swz % 64) / 2; }

DEVI void glds16(const void* g, lchar* l) {
    __builtin_amdgcn_global_load_lds((const __attribute__((address_space(1))) unsigned*)g, (LAS unsigned*)l, 16, 0, 0);
}
constexpr int STG = 32768;
DEVI int stg128(int r, int cb) { return STG + r * 256 + (cb ^ ((r & 15) << 4)); }
DEVI int stg64(int r, int cb) { return STG + r * 128 + (cb ^ ((r & 7) << 4)); }

DEVI void acc_to_lds128(lchar* lds, const f32x4 (&acc)[4][4]) {
    const int tid = vtid(), wid = tid >> 6, lane = tid & 63, wr = wid >> 1, wc = wid & 1, fr = lane & 15, fq = lane >> 4;
#pragma unroll
    for (int m = 0; m < 4; ++m)
#pragma unroll
        for (int n = 0; n < 4; ++n) {
            u32x2 v = {pk2(acc[m][n][0], acc[m][n][1]), pk2(acc[m][n][2], acc[m][n][3])};
            *(LAS u32x2*)(lds + stg128(wr * 64 + m * 16 + fr, (wc * 64 + n * 16 + fq * 4) * 2)) = v;
        }
}
template <int NCOLS>
DEVI void tile_store(lchar* lds, bf16_t* out, size_t ld) {
    constexpr int CPR = NCOLS / 8;
    __syncthreads();
    for (int c = vtid(); c < 128 * CPR; c += 256) {
        const int r = c / CPR, pc = c % CPR;
        const u32x4 v = *(const LAS u32x4*)(lds + (NCOLS == 128 ? stg128(r, pc * 16) : stg64(r, pc * 16)));
        *(u32x4*)(out + (size_t)r * ld + pc * 8) = v;
    }
}

template <class Spec>
DEVI void gemm_phase(lchar* lds0, const Spec& S) {
    constexpr int NKT = Spec::NKT;
    static_assert(NKT % 2 == 0, "NKT must be even");
    const int t512 = ltid(), vb = t512 >> 8, tid = t512 & 255;
    lchar* lds = lds0 + vb * 65536;
    const int VG = gridDim.x * 2, vbid = blockIdx.x * 2 + vb, nu = S.count();
    const int trips = (nu + VG - 1) / VG;
    if (trips == 0) return;
    const int wid = tid >> 6, lane = tid & 63, wr = wid >> 1, wc = wid & 1, fr = lane & 15, fq = lane >> 4;
    int sR[4], sC[4];
#pragma unroll
    for (int i = 0; i < 4; ++i) stage_rc(tid * 16 + i * 4096, sR[i], sC[i]);
    int u = min(vbid, nu - 1);
    const bf16_t* ap[4]; const bf16_t* bp[4];
#pragma unroll
    for (int i = 0; i < 4; ++i) { ap[i] = S.a_row(u, sR[i]) + sC[i]; bp[i] = S.b_row(u, sR[i]) + sC[i]; }
    lchar* sA = lds + wid * 1024; lchar* sB = lds + 16384 + wid * 1024;
    const int aoff = lds_byte(wr * 64 + fr, fq * 8), boff = 16384 + lds_byte(wc * 64 + fr, fq * 8);
#pragma unroll
    for (int i = 0; i < 4; ++i) { glds16(ap[i], sA + i * 4096); glds16(bp[i], sB + i * 4096); }
    for (int trip = 0; trip < trips; ++trip) {
        const bool has_next = trip + 1 < trips;
        const int un = min(vbid + (trip + 1) * VG, nu - 1);
        f32x4 acc[4][4];
#pragma unroll
        for (int m = 0; m < 4; ++m)
#pragma unroll
            for (int n = 0; n < 4; ++n) acc[m][n] = (f32x4){0.f, 0.f, 0.f, 0.f};
        for (int t = 0; t < NKT; ++t) {
            const int cur = t & 1;
            asm volatile("s_waitcnt vmcnt(0)" ::: "memory");
            __syncthreads();
            if (t + 1 < NKT) {
                const int nb = (cur ^ 1) * 32768, ko = (t + 1) * 64;
#pragma unroll
                for (int i = 0; i < 4; ++i) { glds16(ap[i] + ko, sA + nb + i * 4096); glds16(bp[i] + ko, sB + nb + i * 4096); }
            } else if (has_next) {
#pragma unroll
                for (int i = 0; i < 4; ++i) { ap[i] = S.a_row(un, sR[i]) + sC[i]; bp[i] = S.b_row(un, sR[i]) + sC[i]; }
#pragma unroll
                for (int i = 0; i < 4; ++i) { glds16(ap[i], sA + i * 4096); glds16(bp[i], sB + i * 4096); }
            }
            const lchar* A = lds + cur * 32768 + aoff; const lchar* B = lds + cur * 32768 + boff;
#pragma unroll
            for (int ks = 0; ks < 2; ++ks) {
                bf16x8 a[4], b[4];
#pragma unroll
                for (int m = 0; m < 4; ++m) a[m] = *(const LAS bf16x8*)(A + m * 2048 + ks * 1024);
#pragma unroll
                for (int n = 0; n < 4; ++n) b[n] = *(const LAS bf16x8*)(B + n * 2048 + ks * 1024);
#pragma unroll
                for (int m = 0; m < 4; ++m)
#pragma unroll
                    for (int n = 0; n < 4; ++n) acc[m][n] = __builtin_amdgcn_mfma_f32_16x16x32_bf16(b[n], a[m], acc[m][n], 0, 0, 0);
            }
        }
        __syncthreads();
        S.epi(u, acc, lds);
        u = un;
    }
    __syncthreads();
}

struct SrcRow { const float* p; int stride; float mul; };

template <class RF>
DEVI void conv_tile(lchar* lds, const RF& rf, int n0, int k0, bf16_t* dst, int K, const float* kscale) {
    LAS float* t = (LAS float*)lds;
    const int tid = ltid(), nn = tid & 63, kq = tid >> 6;
    const SrcRow sr = rf(n0 + nn);
    const float* src = sr.p + (size_t)(k0 + kq) * sr.stride;
    const size_t step = (size_t)NW * sr.stride;
    float v[64 / NW];
#pragma unroll
    for (int i = 0; i < 64 / NW; ++i) v[i] = src[i * step];
    if (kscale) {
#pragma unroll
        for (int i = 0; i < 64 / NW; ++i) v[i] *= kscale[k0 + kq + i * NW];
    }
#pragma unroll
    for (int i = 0; i < 64 / NW; ++i) t[(kq + i * NW) * 65 + nn] = v[i] * sr.mul;
    __syncthreads();
    {
        const int r = tid >> 3, kc = tid & 7;
        unsigned w[4];
#pragma unroll
        for (int q = 0; q < 4; ++q) w[q] = pk2(t[(kc * 8 + 2 * q) * 65 + r], t[(kc * 8 + 2 * q + 1) * 65 + r]);
        *(uint4*)(dst + (size_t)(n0 + r) * K + k0 + kc * 8) = make_uint4(w[0], w[1], w[2], w[3]);
    }
    __syncthreads();
}

DEVI int rope32_orig(int i) { const int seg = i >> 3, w = i & 7; return (seg == 0 ? 0 : seg == 1 ? 16 : seg == 2 ? 8 : 24) + w; }
DEVI int win_src_col(int r) {
    if (r < 512) return r;
    if (r < 768) { const int h = (r - 512) >> 6, i = (r - 512) & 63; return 512 + h * 96 + i; }
    if (r < 896) { const int h = (r - 768) >> 5, i = (r - 768) & 31; return 512 + h * 96 + 64 + rope32_orig(i); }
    if (r < 1024) return r;
    if (r < 2304) return r + 32;
    if (r < 2336) return 1024 + rope32_orig(r - 2304);
    return -1;
}

DEVI int qperm(int pos) { return ((pos >> 2) & 1) * 16 + (pos >> 3) * 4 + (pos & 3); }
DEVI bool roped64(int g) { return g < 6 || (g >= 16 && g < 22) || g == 12 || g == 13 || g == 36; }
DEVI int win_src_col2(int r) { if (r >= 2336) return -1; return win_src_col(roped64(r >> 6) ? (r & ~31) + qperm(r & 31) : r); }
constexpr int CT_WIN = (NP / 64) * 16, CT_WOUT = 16 * 16, CT_WKV = 8 * 2, CT_SMALL = CT_WIN + CT_WOUT + CT_WKV;
constexpr int CT_GU = 65 * 128, CT_DN = 65 * 64, CT_EXP = CT_GU + CT_DN;

DEVI void conv_small_tile(lchar* lds, const Params& p, int l, int t) {
    char* ws = p.ws;
    if (t < CT_WIN) {
        const int n0 = (t / 16) * 64, k0 = (t % 16) * 64;
        const float* src = p.w_in + (size_t)l * 1024 * IN_W;
        auto rf = [&](int r) { const int c = win_src_col2(r); SrcRow s; s.p = src + (c >= 0 ? c : 0); s.stride = IN_W; s.mul = c >= 0 ? 1.f : 0.f; return s; };
        conv_tile(lds, rf, n0, k0, (bf16_t*)(ws + OFF_WIN) + (size_t)l * NP * 1024, 1024, nullptr);
    } else if (t < CT_WIN + CT_WOUT) {
        t -= CT_WIN;
        const int n0 = (t / 16) * 64, k0 = (t % 16) * 64;
        const float* src = p.w_out + (size_t)l * 1024 * 1024;
        auto rf = [&](int r) { SrcRow s; s.p = src + r; s.stride = 1024; s.mul = 1.f; return s; };
        conv_tile(lds, rf, n0, k0, (bf16_t*)(ws + OFF_WOUT) + (size_t)l * 1024 * 1024, 1024, nullptr);
    } else {
        t -= CT_WIN + CT_WOUT;
        const int n0 = (t / 2) * 64, k0 = (t % 2) * 64;
        const float* src = p.b_w_kv_up + (size_t)l * 128 * 512;
        auto rf = [&](int r) { SrcRow s; s.p = src + r; s.stride = 512; s.mul = 1.f; return s; };
        conv_tile(lds, rf, n0, k0, (bf16_t*)(ws + OFF_WKV) + (size_t)l * 512 * 128, 128, p.b_kv_norm + l * 128);
    }
}
DEVI void conv_exp_tile(lchar* lds, const Params& p, int l, int t) {
    char* ws = p.ws;
    if (t < CT_GU) {
        const int e = t / 128, tt = t % 128, n0 = (tt / 16) * 64, k0 = (tt % 16) * 64;
        const float* g = e < 64 ? p.exp_w_gate + ((size_t)l * 64 + e) * 1024 * 256 : p.sh_w_gate + (size_t)l * 1024 * 256;
        const float* u = e < 64 ? p.exp_w_up + ((size_t)l * 64 + e) * 1024 * 256 : p.sh_w_up + (size_t)l * 1024 * 256;
        auto rf = [&](int r) { const int nt = r >> 8, hf = (r >> 7) & 1, c = r & 127; SrcRow s; s.p = (hf ? u : g) + nt * 128 + c; s.stride = 256; s.mul = 1.f; return s; };
        conv_tile(lds, rf, n0, k0, (bf16_t*)(ws + OFF_WGU) + (size_t)e * 512 * 1024, 1024, nullptr);
    } else {
        t -= CT_GU;
        const int e = t / 64, tt = t % 64, n0 = (tt / 4) * 64, k0 = (tt % 4) * 64;
        const float* d = e < 64 ? p.exp_w_down + ((size_t)l * 64 + e) * 256 * 1024 : p.sh_w_down + (size_t)l * 256 * 1024;
        auto rf = [&](int r) { SrcRow s; s.p = d + r; s.stride = 1024; s.mul = 1.f; return s; };
        conv_tile(lds, rf, n0, k0, (bf16_t*)(ws + OFF_WD) + (size_t)e * 1024 * 256, 256, nullptr);
    }
}


constexpr int CW = (NP / 64) * 4, CO = 16 * 4, CSM = CW + CO;
constexpr int CG = 65 * 8 * 4, CDN = 65 * 16, CEX = CG + CDN;
struct CD { const float* src; int stride; float mul; bf16_t* dst; int n0, k0, K; };
DEVI CD cdesc(const Params& p, int job, int T) {
    const int tid = ltid(), nn = tid & 63, kq = tid >> 6;
    CD d; int t, l;
    bool small = false;
    if (job == 0) { small = true; l = T / CSM; t = T % CSM; } else { l = job == 1 ? 1 : 0; t = T; }
    if (small) {
        if (t < CW) { d.n0 = (t >> 2) * 64; d.k0 = (t & 3) * 256; const int c = win_src_col2(d.n0 + nn);
            d.src = p.w_in + (size_t)l * 1024 * IN_W + (c >= 0 ? c : 0); d.stride = IN_W; d.mul = c >= 0 ? 1.f : 0.f; d.dst = (bf16_t*)(p.ws + OFF_WIN) + (size_t)l * NP * 1024; d.K = 1024; }
        else { t -= CW; d.n0 = (t >> 2) * 64; d.k0 = (t & 3) * 256;
            d.src = p.w_out + (size_t)l * 1024 * 1024 + d.n0 + nn; d.stride = 1024; d.mul = 1.f; d.dst = (bf16_t*)(p.ws + OFF_WOUT) + (size_t)l * 1024 * 1024; d.K = 1024; }
    } else if (t < CG) {
        const int e = t >> 5, tt = t & 31; d.n0 = (tt >> 2) * 64; d.k0 = (tt & 3) * 256;
        const int r = d.n0 + nn, nt = r >> 8, hf = (r >> 7) & 1, c = r & 127;
        const float* g = e < 64 ? p.exp_w_gate + ((size_t)l * 64 + e) * 1024 * 256 : p.sh_w_gate + (size_t)l * 1024 * 256;
        const float* u = e < 64 ? p.exp_w_up + ((size_t)l * 64 + e) * 1024 * 256 : p.sh_w_up + (size_t)l * 1024 * 256;
        d.src = (hf ? u : g) + nt * 128 + c; d.stride = 256; d.mul = 1.f; d.dst = (bf16_t*)(p.ws + OFF_WGU) + (size_t)e * 512 * 1024; d.K = 1024;
    } else {
        t -= CG; const int e = t >> 4; d.n0 = (t & 15) * 64; d.k0 = 0;
        const float* dn = e < 64 ? p.exp_w_down + ((size_t)l * 64 + e) * 256 * 1024 : p.sh_w_down + (size_t)l * 256 * 1024;
        d.src = dn + d.n0 + nn; d.stride = 1024; d.mul = 1.f; d.dst = (bf16_t*)(p.ws + OFF_WD) + (size_t)e * 1024 * 256; d.K = 256;
    }
    d.src += (size_t)(d.k0 + kq) * d.stride;
    return d;
}
DEVI void cload(const CD& d, float (&v)[32]) {
    const size_t step = (size_t)8 * d.stride;
#pragma unroll
    for (int i = 0; i < 32; ++i) v[i] = d.src[i * step];
}
DEVI void cstore(lchar* lds, const CD& d, const float (&v)[32]) {
    LAS float* t = (LAS float*)lds;
    const int tid = ltid(), nn = tid & 63, kq = tid >> 6;
#pragma unroll
    for (int i = 0; i < 32; ++i) t[(kq + i * 8) * 65 + nn] = v[i] * d.mul;
    __syncthreads();
#pragma unroll
    for (int i = 0; i < 4; ++i) {
        const int idx = tid + i * 512, r = (idx >> 2) & 63, kc = (idx & 3) + ((idx >> 8) << 2);
        unsigned w[4];
#pragma unroll
        for (int q = 0; q < 4; ++q) w[q] = pk2(t[(kc * 8 + 2 * q) * 65 + r], t[(kc * 8 + 2 * q + 1) * 65 + r]);
        *(uint4*)(d.dst + (size_t)(d.n0 + r) * d.K + d.k0 + kc * 8) = make_uint4(w[0], w[1], w[2], w[3]);
    }
    __syncthreads();
}
DEVI void conv_stream(lchar* lds, const Params& p, int job, int Tend) {
    const int G = gridDim.x;
    int T = blockIdx.x;
    if (T >= Tend) return;
    CD d = cdesc(p, job, T);
    float a[32];
    cload(d, a);
#pragma unroll 1
    for (;;) {
        const int Tn = T + G; const bool has = Tn < Tend;
        CD dn = d; float b[32];
        if (has) { dn = cdesc(p, job, Tn); cload(dn, b); }
        cstore(lds, d, a);
        if (!has) break;
        d = dn; T = Tn;
#pragma unroll
        for (int i = 0; i < 32; ++i) a[i] = b[i];
    }
}

DEVI void ada_unit(lchar* lds, const Params& p, int u) {
    LAS float* ca = (LAS float*)lds;
    LAS float* red = (LAS float*)(lds + 9 * 1024 * 4);
    const int tid = ltid(), l = u / 96, cg = u % 96, col = cg * 64 + (tid & 63), kq = tid >> 6;
    for (int i = tid; i < 9 * 1024; i += NT) { const float v = i < 8192 ? p.c[i] : p.c_ctx[i - 8192]; ca[i] = silu_f(v); }
    __syncthreads();
    float acc[9];
#pragma unroll
    for (int b = 0; b < 9; ++b) acc[b] = 0.f;
    const float* w = p.ada_w + (size_t)l * 1024 * 6144 + col;
    for (int k0 = kq * (1024 / NW); k0 < (kq + 1) * (1024 / NW); k0 += 16) {
        float wv[16];
#pragma unroll
        for (int i = 0; i < 16; ++i) wv[i] = w[(size_t)(k0 + i) * 6144];
#pragma unroll
        for (int i = 0; i < 16; ++i)
#pragma unroll
            for (int b = 0; b < 9; ++b) acc[b] += ca[b * 1024 + k0 + i] * wv[i];
    }
#pragma unroll
    for (int b = 0; b < 9; ++b) red[(kq * 9 + b) * 64 + (tid & 63)] = acc[b];
    __syncthreads();
    float* mod = (float*)(p.ws + OFF_MOD);
    for (int i = tid; i < 9 * 64; i += NT) {
        const int b = i >> 6, c = i & 63;
        float s = 0.f;
#pragma unroll
        for (int w = 0; w < NW; ++w) s += red[(w * 9 + b) * 64 + c];
        mod[((size_t)l * 9 + b) * 6144 + cg * 64 + c] = s + p.ada_b[l * 6144 + cg * 64 + c];
    }
    __syncthreads();
}

DEVI void rope_tables(const Params& p, int gtid, int gn) {
    float2* th = (float2*)(p.ws + OFF_TABH); float2* tr = (float2*)(p.ws + OFF_TABR);
    for (int i = gtid; i < 2048 * 48; i += gn) {
        const int pos = i / 48, a = i % 48;
        const double row = (double)(pos / 64), col = (double)(pos % 64);
        double ang;
        if (a < 32) { const int q = a & 15; ang = ((a < 16) ? row : col) * pow(10000.0, -(double)q / 16.0); }
        else { const int aa = a - 32, q = aa & 7; ang = ((aa < 8) ? row : col) * pow(10000.0, -(double)q / 8.0); }
        const float2 v = make_float2((float)cos(ang), (float)sin(ang));
        if (a < 32) th[pos * 32 + a] = v; else tr[pos * 16 + (a - 32)] = v;
    }
}

DEVI void phase_s0(lchar* lds, const Params& p) {
    const int G = gridDim.x, bid = blockIdx.x;
    rope_tables(p, bid * NT + ltid(), G * NT);
    { u32x4* wrt = (u32x4*)(p.ws + OFF_WRT);
      for (int i = bid * NT + ltid(); i < 2 * 4 * 32 * 64; i += G * NT) { const int l = i >> 13, w = (i >> 11) & 3, sk = (i >> 6) & 31, ln = i & 63;
          const float* src = p.router_w + ((size_t)l * 1024 + sk * 32 + (ln >> 4) * 8) * 64 + w * 16 + (ln & 15);
          u32x4 hi, lo;
#pragma unroll
          for (int j = 0; j < 4; ++j) { const float a = src[(2 * j) * 64], b = src[(2 * j + 1) * 64]; const unsigned h = pk2(a, b); hi[j] = h; lo[j] = pk2(a - bflo(h), b - bfhi(h)); }
          u32x4* dst = wrt + ((size_t)((l * 4 + w) * 32 + sk) * 2) * 64 + ln;
          dst[0] = hi; dst[64] = lo; } }
    for (int u = bid; u < 192; u += G) ada_unit(lds, p, u);
    for (int t = bid; t < 2 * CT_WKV; t += G) conv_small_tile(lds, p, t / CT_WKV, CT_WIN + CT_WOUT + t % CT_WKV);
    conv_stream(lds, p, 0, 2 * CSM);
}

DEVI const float* xrow_ptr(const Params& p, int l, int r) {
    if (r < T_LAT) return (l == 0 ? p.x : p.out) + (size_t)r * 1024;
    return (l == 0 ? p.ctx : (const float*)(p.ws + OFF_XC)) + (size_t)(r - T_LAT) * 1024;
}
DEVI void phase_s1(const Params& p, int l) {
    const int wid = ltid() >> 6, lane = ltid() & 63;
    const int gw = blockIdx.x * NW + wid, nw = gridDim.x * NW;
    const float* g = p.pre_mix_g + l * 1024;
    bf16_t* H = (bf16_t*)(p.ws + OFF_H);
    for (int r = gw; r < T_ALL; r += nw) {
        const float* xr = xrow_ptr(p, l, r);
        const int bb = r < T_LAT ? (r >> 11) : 8;
        const float* mod = (const float*)(p.ws + OFF_MOD) + ((size_t)l * 9 + bb) * 6144;
        float4 v[4]; float ss = 0.f;
#pragma unroll
        for (int i = 0; i < 4; ++i) { v[i] = *(const float4*)(xr + i * 256 + lane * 4); ss += v[i].x * v[i].x + v[i].y * v[i].y + v[i].z * v[i].z + v[i].w * v[i].w; }
        ss = wave_sum(ss);
        const float rs = rsqrtf(ss * (1.f / 1024.f) + EPS);
#pragma unroll
        for (int i = 0; i < 4; ++i) {
            const int c = i * 256 + lane * 4;
            const float4 gg = *(const float4*)(g + c), sh = *(const float4*)(mod + c), sc = *(const float4*)(mod + 1024 + c);
            const float a0 = v[i].x * rs * gg.x * (1.f + sc.x) + sh.x, a1 = v[i].y * rs * gg.y * (1.f + sc.y) + sh.y;
            const float a2 = v[i].z * rs * gg.z * (1.f + sc.z) + sh.z, a3 = v[i].w * rs * gg.w * (1.f + sc.w) + sh.w;
            *(uint2*)(H + (size_t)r * 1024 + c) = make_uint2(pk2(a0, a1), pk2(a2, a3));
        }
    }
}

struct InprojSpec {
    static constexpr int NKT = 16;
    const Params& p; int l;
    DEVI int count() const { return (T_ALL / 128) * 19; }
    DEVI const bf16_t* a_row(int u, int R) const { return (const bf16_t*)(p.ws + OFF_H) + ((size_t)(u / 19) * 128 + R) * 1024; }
    DEVI const bf16_t* b_row(int u, int R) const { return (const bf16_t*)(p.ws + OFF_WIN) + ((size_t)l * NP + (u % 19) * 128 + R) * 1024; }
    DEVI void epi(int u, f32x4 (&acc)[4][4], lchar* lds) const {
        const int mt = u / 19, nt = u % 19;
        const int tid = vtid(), wid = tid >> 6, lane = tid & 63, wr = wid >> 1, wc = wid & 1, fr = lane & 15, fq = lane >> 4;
        const int g = nt * 2 + wc;
        const bool lat = mt < (T_LAT / 128);
        const bool do_norm = g < 6;
        const int rope = ((g < 6) || (g >= 16 && g < 22)) ? 1 : ((g == 12 || g == 13 || g == 36) ? 2 : 0);
        const float SA = 0.125f * LOG2E, SB = 0.10206207261596577f * LOG2E;
        const float scale = ((g < 4) || (g >= 16 && g < 20) || (g >= 24 && g < 28)) ? SA : ((g >= 8 && g < 14) ? SB : 1.f);
        if (do_norm) {
            const float* gn = (g < 4 ? p.a_q_norm : p.a_k_norm) + l * 64;
            float gv[4][4];
#pragma unroll
            for (int n = 0; n < 4; ++n)
#pragma unroll
                for (int j = 0; j < 4; ++j) gv[n][j] = gn[n * 16 + fq * 4 + j];
#pragma unroll
            for (int m = 0; m < 4; ++m) {
                float ss = 0.f;
#pragma unroll
                for (int n = 0; n < 4; ++n)
#pragma unroll
                    for (int j = 0; j < 4; ++j) ss += acc[m][n][j] * acc[m][n][j];
                ss = rows_sum(ss);
                const float rs = rsqrtf(ss * (1.f / 64.f) + EPS);
#pragma unroll
                for (int n = 0; n < 4; ++n)
#pragma unroll
                    for (int j = 0; j < 4; ++j) acc[m][n][j] *= rs * gv[n][j];
            }
        }
        if (rope != 0 && lat) {
            const float* tab = (const float*)(p.ws + (rope == 1 ? OFF_TABH : OFF_TABR));
            const int tw = rope == 1 ? 32 : 16;
#pragma unroll
            for (int m = 0; m < 4; ++m) {
                const int pos = (mt * 128 + wr * 64 + m * 16 + fr) & 2047;
#pragma unroll
                for (int hf = 0; hf < 2; ++hf) {
                    const int a0 = (rope == 1 ? hf * 16 : 0) + fq * 4;
                    const float4 t0 = *(const float4*)(tab + ((size_t)pos * tw + a0) * 2), t1 = *(const float4*)(tab + ((size_t)pos * tw + a0) * 2 + 4);
                    const float cs[4] = {t0.x, t0.z, t1.x, t1.z}, sn[4] = {t0.y, t0.w, t1.y, t1.w};
#pragma unroll
                    for (int j = 0; j < 4; ++j) {
                        const float x1 = acc[m][2 * hf][j], x2 = acc[m][2 * hf + 1][j];
                        acc[m][2 * hf][j] = x1 * cs[j] - x2 * sn[j];
                        acc[m][2 * hf + 1][j] = x2 * cs[j] + x1 * sn[j];
                    }
                }
            }
        }
        if (scale != 1.f) {
#pragma unroll
            for (int m = 0; m < 4; ++m)
#pragma unroll
                for (int n = 0; n < 4; ++n) acc[m][n] *= scale;
        }
        acc_to_lds128(lds, acc);
        tile_store<128>(lds, (bf16_t*)(p.ws + OFF_P) + (size_t)mt * 128 * NP + nt * 128, NP);
    }
};

struct KvupSpec {
    static constexpr int NKT = 2;
    const Params& p; int l; lchar* lds0;
    DEVI int count() const { return (T_ALL / 128) * 4; }
    DEVI const bf16_t* a_row(int u, int R) const { return (const bf16_t*)(p.ws + OFF_P) + ((size_t)(u >> 2) * 128 + R) * NP + PC_CKV; }
    DEVI const bf16_t* b_row(int u, int R) const { return (const bf16_t*)(p.ws + OFF_WKV) + ((size_t)l * 512 + (u & 3) * 128 + R) * 128; }
    DEVI void epi(int u, f32x4 (&acc)[4][4], lchar* lds) const {
        const int mt = u >> 2, nt = u & 3;
        const int tid = vtid(), wid = tid >> 6, lane = tid & 63, wr = wid >> 1, fr = lane & 15;
        LAS float* rsv = (LAS float*)(lds0 + RSV_OFF + (ltid() >> 8) * 512);
        {
            const int r = tid >> 1, hf = tid & 1;
            const u32x4* src = (const u32x4*)(a_row(u, r) + hf * 64);
            float ss = 0.f;
#pragma unroll
            for (int i = 0; i < 8; ++i) { const u32x4 v = src[i];
#pragma unroll
                for (int q = 0; q < 4; ++q) { const float a = bflo(v[q]), b = bfhi(v[q]); ss += a * a + b * b; } }
            ss += dpp_f<0xB1>(ss);
            if (hf == 0) rsv[r] = rsqrtf(ss * (1.f / 128.f) + EPS);
        }
        __syncthreads();
#pragma unroll
        for (int m = 0; m < 4; ++m) { const float rs = rsv[wr * 64 + m * 16 + fr];
#pragma unroll
            for (int n = 0; n < 4; ++n) acc[m][n] *= rs; }
        acc_to_lds128(lds, acc);
        tile_store<128>(lds, (bf16_t*)(p.ws + OFF_KVB) + (size_t)mt * 128 * NKV + nt * 128, NKV);
    }
};

struct OutprojSpec {
    static constexpr int NKT = 16;
    const Params& p; int l; int nmt;
    DEVI int count() const { return nmt * 8; }
    DEVI const bf16_t* a_row(int u, int R) const { return (const bf16_t*)(p.ws + OFF_MIXIN) + ((size_t)(u >> 3) * 128 + R) * 1024; }
    DEVI const bf16_t* b_row(int u, int R) const { return (const bf16_t*)(p.ws + OFF_WOUT) + ((size_t)l * 1024 + (u & 7) * 128 + R) * 1024; }
    DEVI void epi(int u, f32x4 (&acc)[4][4], lchar* lds) const {
        acc_to_lds128(lds, acc);
        tile_store<128>(lds, (bf16_t*)(p.ws + OFF_MIX) + (size_t)(u >> 3) * 128 * 1024 + (u & 7) * 128, 1024);
    }
};

DEVI void build_seg(lchar* lds, const Params& p) {
    LAS int* seg = (LAS int*)(lds + SEG_OFF);
    const int* cnt = (const int*)(p.ws + OFF_CNT);
    if (ltid() < 64) {
        const int lane = ltid(), pc = (cnt[lane] + 255) & ~255;
        int inc = 0;
#pragma unroll
        for (int j = 0; j < 64; ++j) { const int sj = __builtin_amdgcn_readlane(pc, j); if (lane >= j) inc += sj; }
        seg[lane] = inc - pc;
        if (lane == 63) seg[64] = inc;
    }
    __syncthreads();
}
DEVI int seg_expert(lchar* lds, int slot) {
    LAS int* seg = (LAS int*)(lds + SEG_OFF);
    int e = 0;
#pragma unroll
    for (int s = 32; s; s >>= 1) if (seg[e + s] <= slot) e += s;
    return e;
}

struct GateupSpec {
    static constexpr int NKT = 16;
    const Params& p; lchar* lds; int nmt_r, nmt_all;
    DEVI int count() const { return (nmt_r + nmt_all) * 4; }
    DEVI const bf16_t* a_row(int u, int R) const {
        const int mt = u >> 2; const bf16_t* H = (const bf16_t*)(p.ws + OFF_H);
        if (mt >= nmt_r) return H + ((size_t)(mt - nmt_r) * 128 + R) * 1024;
        return H + (size_t)((const int*)(p.ws + OFF_STK))[mt * 128 + R] * 1024;
    }
    DEVI const bf16_t* b_row(int u, int R) const {
        const int mt = u >> 2, e = mt >= nmt_r ? 64 : seg_expert(lds, mt * 128);
        return (const bf16_t*)(p.ws + OFF_WGU) + ((size_t)e * 512 + (u & 3) * 128 + R) * 1024;
    }
    DEVI void epi(int u, f32x4 (&acc)[4][4], lchar* l_) const {
        const int mt = u >> 2, nt = u & 3, row0 = mt >= nmt_r ? SH_BASE + (mt - nmt_r) * 128 : mt * 128;
        const int tid = vtid(), wid = tid >> 6, lane = tid & 63, wr = wid >> 1, wc = wid & 1, fr = lane & 15, fq = lane >> 4;
#pragma unroll
        for (int m = 0; m < 4; ++m)
#pragma unroll
            for (int hf = 0; hf < 2; ++hf) {
                float a[4];
#pragma unroll
                for (int j = 0; j < 4; ++j) a[j] = silu_f(acc[m][2 * hf][j]) * acc[m][2 * hf + 1][j];
                u32x2 v = {pk2(a[0], a[1]), pk2(a[2], a[3])};
                *(LAS u32x2*)(l_ + stg64(wr * 64 + m * 16 + fr, (wc * 32 + hf * 16 + fq * 4) * 2)) = v;
            }
        tile_store<64>(l_, (bf16_t*)(p.ws + OFF_ACT) + (size_t)row0 * 256 + nt * 64, 256);
    }
};

struct DownSpec {
    static constexpr int NKT = 4;
    const Params& p; lchar* lds; int nmt_r, nmt_all;
    DEVI int count() const { return (nmt_r + nmt_all) * 8; }
    DEVI int row0(int mt) const { return mt >= nmt_r ? SH_BASE + (mt - nmt_r) * 128 : mt * 128; }
    DEVI const bf16_t* a_row(int u, int R) const { return (const bf16_t*)(p.ws + OFF_ACT) + ((size_t)row0(u >> 3) + R) * 256; }
    DEVI const bf16_t* b_row(int u, int R) const {
        const int mt = u >> 3, e = mt >= nmt_r ? 64 : seg_expert(lds, mt * 128);
        return (const bf16_t*)(p.ws + OFF_WD) + ((size_t)e * 1024 + (u & 7) * 128 + R) * 256;
    }
    DEVI void epi(int u, f32x4 (&acc)[4][4], lchar* l_) const {
        const int mt = u >> 3, nt = u & 7;
        acc_to_lds128(l_, acc);
        bf16_t* out = mt >= nmt_r ? (bf16_t*)(p.ws + OFF_H) + (size_t)(mt - nmt_r) * 128 * 1024 : (bf16_t*)(p.ws + OFF_Y) + (size_t)mt * 128 * 1024;
        tile_store<128>(l_, out + nt * 128, 1024);
    }
};

DEVI int perm32(int rho) { const int n = rho >> 4, i = rho & 15; return 8 * (i >> 2) + 4 * n + (i & 3); }
template <class Spec>
DEVI void gemm8_phase(lchar* lds, const Spec& S) {
    constexpr int K = Spec::K, NKT = K / 64, HTB = 16384;
    static_assert(NKT % 2 == 0 && NKT >= 2, "K must be a multiple of 128");
    int u = S.unit(0);
    if (u < 0) return;
    const int tid = ltid(), wid = __builtin_amdgcn_readfirstlane(tid >> 6), lane = tid & 63, wr = wid >> 2, wc = wid & 3, fr = lane & 15, fq = lane >> 4;
    int sR[2], sC[2]; unsigned voffB[2];
#pragma unroll
    for (int i = 0; i < 2; ++i) { stage_rc(tid * 16 + i * 8192, sR[i], sC[i]); const int Rb = (sR[i] & ~31) + perm32(sR[i] & 31); voffB[i] = (unsigned)(Rb * K + sC[i]) * 2u; }
    constexpr size_t kstep = 128, hstepB = (size_t)128 * K * 2;
    const unsigned ldsw = (unsigned)wid * 1024u;
    const int aoff = lds_byte(wr * 64 + fr, fq * 8), boff = lds_byte(wc * 32 + fr, fq * 8);
#define G8_SA(b, h) (((b) * 2 + (h)) * HTB)
#define G8_SB(b, h) ((4 + (b) * 2 + (h)) * HTB)
#define G8_STAGE(bufoff, gbase, voff) do { _Pragma("unroll") for (int _i = 0; _i < 2; ++_i) \
        __builtin_amdgcn_global_load_lds((const __attribute__((address_space(1))) unsigned*)((const char*)(gbase) + (voff)[_i]), (LAS unsigned*)(lds + (bufoff) + ldsw + _i * 8192), 16, 0, 0); } while (0)
#define G8_LDA(dst, b, h) do { _Pragma("unroll") for (int m = 0; m < 4; ++m) _Pragma("unroll") for (int k = 0; k < 2; ++k) dst[m][k] = *(const LAS bf16x8*)(lds + G8_SA(b, h) + aoff + m * 2048 + k * 1024); } while (0)
#define G8_LDB(dst, b, h) do { _Pragma("unroll") for (int n = 0; n < 2; ++n) _Pragma("unroll") for (int k = 0; k < 2; ++k) dst[n][k] = *(const LAS bf16x8*)(lds + G8_SB(b, h) + boff + n * 2048 + k * 1024); } while (0)
#define G8_MMA(ai, bj, At, Bt) do { __builtin_amdgcn_s_setprio(1); _Pragma("unroll") for (int m = 0; m < 4; ++m) _Pragma("unroll") for (int n = 0; n < 2; ++n) _Pragma("unroll") for (int k = 0; k < 2; ++k) \
        acc[ai][bj][m][n] = __builtin_amdgcn_mfma_f32_16x16x32_bf16(Bt[n][k], At[m][k], acc[ai][bj][m][n], 0, 0, 0); __builtin_amdgcn_s_setprio(0); } while (0)
#define G8_WAIT_V(n) asm volatile("s_waitcnt vmcnt(" #n ")" ::: "memory")
#define G8_WAIT_L(n) asm volatile("s_waitcnt lgkmcnt(" #n ")" ::: "memory")
#define G8_BAR __builtin_amdgcn_s_barrier()
#define G8_SCHED __builtin_amdgcn_sched_barrier(0)
    f32x4 acc[2][2][4][2];
#pragma unroll
    for (int a = 0; a < 2; ++a)
#pragma unroll
        for (int b = 0; b < 2; ++b)
#pragma unroll
            for (int m = 0; m < 4; ++m)
#pragma unroll
                for (int n = 0; n < 2; ++n) acc[a][b][m][n] = (f32x4){0.f, 0.f, 0.f, 0.f};
    bf16x8 At[4][2], B0[2][2], B1[2][2];
    constexpr bool GATHER = Spec::GATHER;
    unsigned voffA[2][2];
    constexpr size_t hstepA = GATHER ? 0 : (size_t)128 * Spec::APITCH * 2;
    const char* cA; int ui = 0;
    if constexpr (GATHER) {
        const u32x4 o = *(const u32x4*)S.goff(0);
        voffA[0][0] = o[0]; voffA[0][1] = o[1]; voffA[1][0] = o[2]; voffA[1][1] = o[3];
        cA = S.a_base();
    } else {
#pragma unroll
        for (int i = 0; i < 2; ++i) { voffA[0][i] = (unsigned)(sR[i] * Spec::APITCH + sC[i]) * 2u; voffA[1][i] = voffA[0][i]; }
        cA = S.a_tile(u);
    }
    const char* cB = S.b_tile(u);
    G8_STAGE(G8_SB(0, 0), cB, voffB); G8_STAGE(G8_SB(0, 1), cB + hstepB, voffB); G8_STAGE(G8_SA(0, 0), cA, voffA[0]); G8_STAGE(G8_SA(0, 1), cA + hstepA, voffA[1]);
    if (wr == 1) G8_BAR;
    G8_WAIT_V(2); G8_BAR;
    G8_STAGE(G8_SB(1, 0), cB + kstep, voffB); G8_STAGE(G8_SA(1, 0), cA + kstep, voffA[0]); G8_STAGE(G8_SB(1, 1), cB + hstepB + kstep, voffB);
    G8_WAIT_V(6); G8_BAR;
    for (;;) {
        const int un = S.unit(ui + 1); const bool has_next = un >= 0;
        const char* nA; const char* nB = has_next ? S.b_tile(un) : cB;
        if constexpr (GATHER) { nA = cA;
            if (has_next) __builtin_amdgcn_global_load_lds((const __attribute__((address_space(1))) unsigned*)S.goff(ui + 1), (LAS unsigned*)(lds + GOFF_LDS + ldsw), 16, 0, 0);
        } else nA = has_next ? S.a_tile(un) : cA;
#pragma unroll 1
        for (int t = 0; t < NKT; t += 2) {
            const bool last = (t == NKT - 2);
            const char* a1 = cA + (size_t)(t + 1) * kstep;
            const char* a2 = last ? nA : cA + (size_t)(t + 2) * kstep; const char* b2 = last ? nB : cB + (size_t)(t + 2) * kstep;
            const char* a3 = a2 + kstep; const char* b3 = b2 + kstep;
            G8_LDB(B0, 0, 0); G8_LDB(B1, 0, 1); G8_SCHED; G8_LDA(At, 0, 0); G8_STAGE(G8_SA(1, 1), a1 + hstepA, voffA[1]);
            if constexpr (GATHER) { if (last && has_next) { const u32x4 o = *(const LAS u32x4*)(lds + GOFF_LDS + tid * 16);
                voffA[0][0] = o[0]; voffA[0][1] = o[1]; voffA[1][0] = o[2]; voffA[1][1] = o[3]; } }
            G8_WAIT_V(8); G8_WAIT_L(0); G8_BAR; G8_MMA(0, 0, At, B0); G8_MMA(0, 1, At, B1); G8_BAR; G8_SCHED;
            G8_LDA(At, 0, 1); G8_STAGE(G8_SB(0, 0), b2, voffB); G8_STAGE(G8_SB(0, 1), b2 + hstepB, voffB); G8_STAGE(G8_SA(0, 0), a2, voffA[0]);
            G8_WAIT_V(8); G8_WAIT_L(0); G8_BAR; G8_MMA(1, 0, At, B0); G8_MMA(1, 1, At, B1); G8_BAR; G8_SCHED;
            G8_LDB(B0, 1, 0); G8_LDB(B1, 1, 1); G8_SCHED; G8_LDA(At, 1, 0); G8_STAGE(G8_SA(0, 1), a2 + hstepA, voffA[1]);
            G8_WAIT_V(8); G8_WAIT_L(0); G8_BAR; G8_MMA(0, 0, At, B0); G8_MMA(0, 1, At, B1); G8_BAR; G8_SCHED;
            G8_LDA(At, 1, 1); G8_STAGE(G8_SB(1, 0), b3, voffB); G8_STAGE(G8_SB(1, 1), b3 + hstepB, voffB); G8_STAGE(G8_SA(1, 0), a3, voffA[0]);
            G8_WAIT_V(8); G8_WAIT_L(0); G8_BAR; G8_MMA(1, 0, At, B0); G8_MMA(1, 1, At, B1); G8_BAR; G8_SCHED;
        }
        if constexpr (Spec::ALIGN) { if (wr == 0) G8_BAR; }
        S.epi(u, acc, wr, wc, fr, fq);
        if (!has_next) break;
#pragma unroll
        for (int a = 0; a < 2; ++a)
#pragma unroll
            for (int b = 0; b < 2; ++b)
#pragma unroll
                for (int m = 0; m < 4; ++m)
#pragma unroll
                    for (int n = 0; n < 2; ++n) acc[a][b][m][n] = (f32x4){0.f, 0.f, 0.f, 0.f};
        u = un; cA = nA; cB = nB; ++ui;
        if constexpr (Spec::ALIGN) { if (wr == 1) G8_BAR; }
    }
    G8_WAIT_V(0);
    if constexpr (!Spec::ALIGN) { if (wr == 0) G8_BAR; }
    G8_BAR;
#undef G8_SA
#undef G8_SB
#undef G8_STAGE
#undef G8_LDA
#undef G8_LDB
#undef G8_MMA
#undef G8_WAIT_V
#undef G8_WAIT_L
#undef G8_BAR
#undef G8_SCHED
}

DEVI void g8_store_bf16(const f32x4 (&acc)[2][2][4][2], bf16_t* out  , size_t ld, int wr, int wc, int fr, int fq) {
    asm volatile("" : "+v"(fr), "+v"(fq));
#pragma unroll
    for (int ai = 0; ai < 2; ++ai)
#pragma unroll
        for (int m = 0; m < 4; ++m) { bf16_t* rowp = out + (size_t)(ai * 128 + wr * 64 + m * 16 + fr) * ld + wc * 32 + 8 * fq;
#pragma unroll
            for (int bj = 0; bj < 2; ++bj) { const f32x4 v0 = acc[ai][bj][m][0], v1 = acc[ai][bj][m][1];
                u32x4 w = {pk2(v0[0], v0[1]), pk2(v0[2], v0[3]), pk2(v1[0], v1[1]), pk2(v1[2], v1[3])};
                *(u32x4*)(rowp + bj * 128) = w; } }
}

struct Outproj8 {
    static constexpr int K = 1024, APITCH = 1024; static constexpr bool GATHER = false, ALIGN = true;
    const Params& p; int l; int nmt;
    DEVI int count() const { return nmt * 4; }
    DEVI int unit(int k) const { const int u = blockIdx.x + k * (int)gridDim.x; return u < count() ? u : -1; }
    DEVI const char* a_tile(int u) const { return p.ws + OFF_MIXIN + (size_t)(u >> 2) * 256 * 1024 * 2; }
    DEVI const char* b_tile(int u) const { return p.ws + OFF_WOUT + ((size_t)l * 1024 + (u & 3) * 256) * 1024 * 2; }
    DEVI void epi(int u, const f32x4 (&acc)[2][2][4][2], int wr, int wc, int fr, int fq) const {
        g8_store_bf16(acc, (bf16_t*)(p.ws + OFF_MIX) + (size_t)(u >> 2) * 256 * 1024 + (u & 3) * 256, 1024, wr, wc, fr, fq);
    }
};

struct Inproj8 {
    static constexpr int K = 1024, APITCH = 1024; static constexpr bool GATHER = false, ALIGN = true;
    const Params& p; int l; lchar* lds;
    DEVI int count() const { return (T_ALL / 256) * 10; }
    DEVI int unit(int k) const { const int u = blockIdx.x + k * (int)gridDim.x; return u < count() ? u : -1; }
    DEVI const char* a_tile(int u) const { return p.ws + OFF_H + (size_t)(u / 10) * 256 * 1024 * 2; }
    DEVI const char* b_tile(int u) const { return p.ws + OFF_WIN + ((size_t)l * NP + (u % 10) * 256) * 1024 * 2; }
    DEVI void epi(int u, f32x4 (&acc)[2][2][4][2], int wr, int wc, int fr, int fq) const {
        asm volatile("" : "+v"(fr), "+v"(fq));
        const int pm = u / 10, pn = u % 10;
        const bool lat = pm < (T_LAT / 256);
        const float SA = 0.125f * LOG2E, SB = 0.10206207261596577f * LOG2E;
        LAS float* P = (LAS float*)(lds + GOFF_LDS);
        if (pn < 2 || pn == 3) {
#pragma unroll
            for (int bj = 0; bj < 2; ++bj)
#pragma unroll
                for (int ai = 0; ai < 2; ++ai)
#pragma unroll
                    for (int m = 0; m < 4; ++m) {
                        float ss = 0.f;
#pragma unroll
                        for (int n = 0; n < 2; ++n)
#pragma unroll
                            for (int j = 0; j < 4; ++j) ss += acc[ai][bj][m][n][j] * acc[ai][bj][m][n][j];
                        ss = rows_sum(ss);
                        if (fq == 0) P[((ai * 128 + wr * 64 + m * 16 + fr) * 2 + bj) * 4 + wc] = ss;
                    }
            asm volatile("s_waitcnt lgkmcnt(0)" ::: "memory"); __builtin_amdgcn_s_barrier(); asm volatile("" ::: "memory");
        }
#pragma unroll
        for (int bj = 0; bj < 2; ++bj) {
            const int g = 4 * pn + 2 * bj + (wc >> 1), hf = wc & 1;
            const int rope = ((g < 6) || (g >= 16 && g < 22)) ? 1 : ((g == 12 || g == 13 || g == 36) ? 2 : 0);
            const float scale = ((g < 4) || (g >= 16 && g < 20) || (g >= 24 && g < 28)) ? SA : ((g >= 8 && g < 14) ? SB : 1.f);
            if (g < 6) {
                const float* gn = (g < 4 ? p.a_q_norm : p.a_k_norm) + l * 64 + hf * 32 + 4 * fq;
                const float4 g0 = *(const float4*)gn, g1 = *(const float4*)(gn + 16);
                const float gv[2][4] = {{g0.x, g0.y, g0.z, g0.w}, {g1.x, g1.y, g1.z, g1.w}};
#pragma unroll
                for (int ai = 0; ai < 2; ++ai)
#pragma unroll
                    for (int m = 0; m < 4; ++m) {
                        const int row = ai * 128 + wr * 64 + m * 16 + fr;
                        const float ss = P[(row * 2 + bj) * 4 + wc] + P[(row * 2 + bj) * 4 + (wc ^ 1)];
                        const float rs = rsqrtf(ss * (1.f / 64.f) + EPS);
#pragma unroll
                        for (int n = 0; n < 2; ++n)
#pragma unroll
                            for (int j = 0; j < 4; ++j) acc[ai][bj][m][n][j] *= rs * gv[n][j];
                    }
            }
            if (g == 14 || g == 15) {
#pragma unroll
                for (int ai = 0; ai < 2; ++ai)
#pragma unroll
                    for (int m = 0; m < 4; ++m) {
                        const int row = ai * 128 + wr * 64 + m * 16 + fr;
                        const f32x4 ps = *(const LAS f32x4*)(P + (row * 2 + bj) * 4);
                        const float rs = rsqrtf((ps[0] + ps[1] + ps[2] + ps[3]) * (1.f / 128.f) + EPS);
#pragma unroll
                        for (int n = 0; n < 2; ++n) acc[ai][bj][m][n] *= rs;
                    }
            }
            if (rope != 0 && lat) {
                const float* tab = (const float*)(p.ws + (rope == 1 ? OFF_TABH : OFF_TABR));
                const int tw = rope == 1 ? 32 : 16, a0 = (rope == 1 ? hf * 16 : 0) + fq * 4;
#pragma unroll
                for (int ai = 0; ai < 2; ++ai)
#pragma unroll
                    for (int m = 0; m < 4; ++m) {
                        const int pos = (pm * 256 + ai * 128 + wr * 64 + m * 16 + fr) & 2047;
                        const float4 t0 = *(const float4*)(tab + ((size_t)pos * tw + a0) * 2), t1 = *(const float4*)(tab + ((size_t)pos * tw + a0) * 2 + 4);
                        const float cs[4] = {t0.x, t0.z, t1.x, t1.z}, sn[4] = {t0.y, t0.w, t1.y, t1.w};
#pragma unroll
                        for (int j = 0; j < 4; ++j) {
                            const float x1 = acc[ai][bj][m][0][j], x2 = acc[ai][bj][m][1][j];
                            acc[ai][bj][m][0][j] = x1 * cs[j] - x2 * sn[j];
                            acc[ai][bj][m][1][j] = x2 * cs[j] + x1 * sn[j];
                        }
                        if (m & 1) __builtin_amdgcn_sched_barrier(0);
                    }
            }
            bf16_t* out = (bf16_t*)(p.ws + OFF_P) + (size_t)pm * 256 * NP + pn * 256 + bj * 128 + wc * 32 + 8 * fq;
#pragma unroll
            for (int ai = 0; ai < 2; ++ai)
#pragma unroll
                for (int m = 0; m < 4; ++m) {
                    const f32x4 v0 = acc[ai][bj][m][0] * scale, v1 = acc[ai][bj][m][1] * scale;
                    u32x4 w = {pk2(v0[0], v0[1]), pk2(v0[2], v0[3]), pk2(v1[0], v1[1]), pk2(v1[2], v1[3])};
                    *(u32x4*)(out + (size_t)(ai * 128 + wr * 64 + m * 16 + fr) * NP) = w;
                }
        }
    }
};

struct Kvup8 {
    static constexpr int K = 128, APITCH = NP; static constexpr bool GATHER = false, ALIGN = false;
    const Params& p; int l;
    DEVI int count() const { return (T_ALL / 256) * 2; }
    DEVI int unit(int k) const { const int u = blockIdx.x + k * (int)gridDim.x; return u < count() ? u : -1; }
    DEVI const char* a_tile(int u) const { return p.ws + OFF_P + ((size_t)(u >> 1) * 256 * NP + PC_CKV) * 2; }
    DEVI const char* b_tile(int u) const { return p.ws + OFF_WKV + ((size_t)l * 512 + (u & 1) * 256) * 128 * 2; }
    DEVI void epi(int u, const f32x4 (&acc)[2][2][4][2], int wr, int wc, int fr, int fq) const {
        g8_store_bf16(acc, (bf16_t*)(p.ws + OFF_KVB) + (size_t)(u >> 1) * 256 * NKV + (u & 1) * 256, NKV, wr, wc, fr, fq);
    }
};

struct Gateup8 {
    static constexpr int K = 1024, APITCH = 1024; static constexpr bool GATHER = true, ALIGN = true;
    const Params& p; lchar* lds; int nmt_r, nmt_sh;
    DEVI int count() const { return (nmt_r + nmt_sh) * 2; }
    DEVI int unit(int k) const { const int u = blockIdx.x + k * (int)gridDim.x; return u < count() ? u : -1; }
    DEVI const char* a_base() const { return p.ws + OFF_H; }
    DEVI const char* a_tile(int) const { return p.ws + OFF_H; }
    DEVI const char* goff(int k) const { const char* b = p.ws + OFF_GOFF + ((size_t)blockIdx.x * 8 + k) * 8192; asm volatile("" : "+s"(b)); return b + ltid() * 16; }
    DEVI const char* b_tile(int u) const {
        const int mt = u >> 1, e = mt >= nmt_r ? 64 : __builtin_amdgcn_readfirstlane(seg_expert(lds, mt * 256));
        return p.ws + OFF_WGU + ((size_t)e * 512 + (u & 1) * 256) * 1024 * 2;
    }
    DEVI void epi(int u, const f32x4 (&acc)[2][2][4][2], int wr, int wc, int fr, int fq) const {
        const int mt = u >> 1, row0 = mt >= nmt_r ? SH_BASE + (mt - nmt_r) * 256 : mt * 256;
        bf16_t* out = (bf16_t*)(p.ws + OFF_ACT) + (size_t)row0 * 256 + (u & 1) * 128 + wc * 32 + 8 * fq;
#pragma unroll
        for (int ai = 0; ai < 2; ++ai)
#pragma unroll
            for (int m = 0; m < 4; ++m) {
                float a[8];
#pragma unroll
                for (int n = 0; n < 2; ++n)
#pragma unroll
                    for (int j = 0; j < 4; ++j) a[n * 4 + j] = silu_f(acc[ai][0][m][n][j]) * acc[ai][1][m][n][j];
                u32x4 w = {pk2(a[0], a[1]), pk2(a[2], a[3]), pk2(a[4], a[5]), pk2(a[6], a[7])};
                *(u32x4*)(out + (size_t)(ai * 128 + wr * 64 + m * 16 + fr) * 256) = w;
            }
    }
};
template <class Spec> DEVI void build_goff(const Params& p, int nmt_r, const Spec& S) {
    const int tid = ltid();
    int sR[2], sC[2];
#pragma unroll
    for (int i = 0; i < 2; ++i) stage_rc(tid * 16 + i * 8192, sR[i], sC[i]);
    const int* stk = (const int*)(p.ws + OFF_STK);
    u32x4* tab = (u32x4*)(p.ws + OFF_GOFF) + (size_t)blockIdx.x * 8 * 512 + tid;
    u32x4 o[8];
#pragma unroll
    for (int k = 0; k < 8; ++k) {
        const int u = S.unit(k); const int mt = u >> 1;
#pragma unroll
        for (int h = 0; h < 2; ++h)
#pragma unroll
            for (int i = 0; i < 2; ++i) { const int row = h * 128 + sR[i]; const int tok = u < 0 ? 0 : mt >= nmt_r ? (mt - nmt_r) * 256 + row : stk[mt * 256 + row];
                o[k][h * 2 + i] = (unsigned)(tok * 1024 + sC[i]) * 2u; }
    }
#pragma unroll
    for (int k = 0; k < 8; ++k) if (S.unit(k) >= 0) tab[(size_t)k * 512] = o[k];
    asm volatile("s_waitcnt vmcnt(0)" ::: "memory");
    __syncthreads();
}

struct Down8 {
    static constexpr int K = 256, APITCH = 256; static constexpr bool GATHER = false, ALIGN = true;
    const Params& p; lchar* lds; int nmt_r, nmt_sh;
    bool y8;
    DEVI int count() const { return (nmt_r + nmt_sh) * 4; }
    DEVI int unit(int k) const {
        const int nmt = nmt_r + nmt_sh, NQ = (int)gridDim.x >> 3, x = blockIdx.x & 7, q = blockIdx.x >> 3, R = (nmt + 7) >> 3;
        if ((gridDim.x & 7) != 0) { const int u = blockIdx.x + k * (int)gridDim.x; return u < count() ? u : -1; }
        const int idx = k * NQ + q, mtl = idx >> 2, mt = x * R + mtl;
        return (mtl < R && mt < nmt) ? mt * 4 + (idx & 3) : -1;
    }
    DEVI int row0(int mt) const { return mt >= nmt_r ? SH_BASE + (mt - nmt_r) * 256 : mt * 256; }
    DEVI const char* a_tile(int u) const { return p.ws + OFF_ACT + (size_t)row0(u >> 2) * 256 * 2; }
    DEVI const char* b_tile(int u) const {
        const int mt = u >> 2, e = mt >= nmt_r ? 64 : __builtin_amdgcn_readfirstlane(seg_expert(lds, mt * 256));
        return p.ws + OFF_WD + ((size_t)e * 1024 + (u & 3) * 256) * 256 * 2;
    }
    DEVI void epi(int u, const f32x4 (&acc)[2][2][4][2], int wr, int wc, int fr, int fq) const {
        const int mt = u >> 2;
        if (y8 && mt < nmt_r) {
            asm volatile("" : "+v"(fr), "+v"(fq));
            unsigned char* o8 = (unsigned char*)(p.ws + OFF_Y) + (size_t)mt * 256 * 1024 + (u & 3) * 256 + wc * 32 + 8 * fq;
#pragma unroll
            for (int ai = 0; ai < 2; ++ai)
#pragma unroll
                for (int m = 0; m < 4; ++m)
#pragma unroll
                    for (int bj = 0; bj < 2; ++bj) {
                        f32x4 v0 = acc[ai][bj][m][0] * 64.f, v1 = acc[ai][bj][m][1] * 64.f;
#pragma unroll
                        for (int q = 0; q < 4; ++q) { v0[q] = fminf(fmaxf(v0[q], -448.f), 448.f); v1[q] = fminf(fmaxf(v1[q], -448.f), 448.f); }
                        int w0 = __builtin_amdgcn_cvt_pk_fp8_f32(v0[0], v0[1], 0, false); w0 = __builtin_amdgcn_cvt_pk_fp8_f32(v0[2], v0[3], w0, true);
                        int w1 = __builtin_amdgcn_cvt_pk_fp8_f32(v1[0], v1[1], 0, false); w1 = __builtin_amdgcn_cvt_pk_fp8_f32(v1[2], v1[3], w1, true);
                        *(u32x2*)(o8 + (size_t)(ai * 128 + wr * 64 + m * 16 + fr) * 1024 + bj * 128) = (u32x2){(unsigned)w0, (unsigned)w1};
                    }
            return;
        }
        bf16_t* out = mt >= nmt_r ? (bf16_t*)(p.ws + OFF_H) + (size_t)(mt - nmt_r) * 256 * 1024 : (bf16_t*)(p.ws + OFF_Y) + (size_t)mt * 256 * 1024;
        g8_store_bf16(acc, out + (u & 3) * 256, 1024, wr, wc, fr, fq);
    }
};

DEVI Params ldp() {
#if defined(__HIP_DEVICE_COMPILE__)
    const __attribute__((address_space(4))) Params* kp = (const __attribute__((address_space(4))) Params*)__builtin_amdgcn_kernarg_segment_ptr();
    asm volatile("" : "+s"(kp));
    return *kp;
#else
    return Params{};
#endif
}
constexpr int CB_OFF = 124928, CB_GRP = 1040, CB_BUF = 16 * CB_GRP;
constexpr int NCHUNK = 65 * 192;
constexpr int CD_OFF = CB_OFF + 2 * CB_BUF, CD_MAX = 52;
static_assert(CD_OFF + CD_MAX * 32 <= LDS_XB, "chunk descriptor table");
struct ConvRide { int j, nj, pend; };
struct CChunk { const float* src; int stride; bf16_t* dst; int K; };
DEVI CChunk cchunk(const Params& p, int l, int c) {
    const int e = c / 192, r = c - e * 192;
    CChunk d;
    if (r < 128) {
        const int blk = r >> 4, kb = r & 15, nt = blk >> 2, hf = (blk >> 1) & 1, c0 = (blk & 1) * 64;
        const float* g = e < 64 ? p.exp_w_gate + ((size_t)l * 64 + e) * 1024 * 256 : p.sh_w_gate + (size_t)l * 1024 * 256;
        const float* u = e < 64 ? p.exp_w_up + ((size_t)l * 64 + e) * 1024 * 256 : p.sh_w_up + (size_t)l * 1024 * 256;
        d.src = (hf ? u : g) + nt * 128 + c0 + (size_t)kb * 64 * 256; d.stride = 256;
        d.dst = (bf16_t*)(p.ws + OFF_WGU) + ((size_t)e * 512 + blk * 64) * 1024 + kb * 64; d.K = 1024;
    } else {
        const int rr = r - 128, nb = rr >> 2, kb = rr & 3;
        const float* dn = e < 64 ? p.exp_w_down + ((size_t)l * 64 + e) * 256 * 1024 : p.sh_w_down + (size_t)l * 256 * 1024;
        d.src = dn + nb * 64 + (size_t)kb * 64 * 1024; d.stride = 1024;
        d.dst = (bf16_t*)(p.ws + OFF_WD) + ((size_t)e * 1024 + nb * 64) * 256 + kb * 64; d.K = 256;
    }
    return d;
}
DEVI void cride_table(lchar* lds, const Params& p, int l, int base, int n) {
    const int t = ltid();
    if (t < n) {
        const CChunk d = cchunk(p, l, blockIdx.x + (base + t) * gridDim.x);
        const unsigned long long sa = (unsigned long long)d.src, da = (unsigned long long)d.dst;
        *(LAS u32x4*)(lds + CD_OFF + t * 32) = (u32x4){(unsigned)sa, (unsigned)(sa >> 32), (unsigned)da, (unsigned)(da >> 32)};
        *(LAS u32x2*)(lds + CD_OFF + t * 32 + 16) = (u32x2){(unsigned)d.stride * 4u, (unsigned)d.K};
    }
    __syncthreads();
}
DEVI void cride_entry(lchar* lds, int j, u32x4& e0, u32x2& e1) {
    const unsigned a = (unsigned)(__UINTPTR_TYPE__)(lds + CD_OFF) + (unsigned)j * 32u;
    asm volatile("ds_read_b128 %0, %2\n\tds_read_b64 %1, %2 offset:16\n\ts_waitcnt lgkmcnt(0)" : "=&v"(e0), "=&v"(e1) : "v"(a) : "memory");
}
DEVI void cride_issue(lchar* lds, int j, int boff) {
    const int tid = ltid(), w = __builtin_amdgcn_readfirstlane(tid >> 6), lane = tid & 63;
    u32x4 e0; u32x2 e1; cride_entry(lds, j, e0, e1);
    const unsigned long long sa = ((unsigned long long)e0[1] << 32) | e0[0];
    const char* g = (const char*)sa + (size_t)((unsigned)(w * 4 + (lane >> 4)) * e1[0]) + (lane & 15) * 16;
    lchar* dl = lds + boff + w * CB_GRP;
    glds16(g, dl); glds16(g + (size_t)(32u * e1[0]), dl + 8 * CB_GRP);
}
DEVI void cride_consume(lchar* lds, int j, int boff) {
    const int tid = ltid(), w = tid >> 6, lane = tid & 63, nl = w * 8 + (lane >> 3), kc = lane & 7;
    u32x4 e0; u32x2 e1; cride_entry(lds, j, e0, e1);
    const unsigned a = (unsigned)(__UINTPTR_TYPE__)(lds + boff + kc * 2 * CB_GRP + nl * 4);
    float v0, v1, v2, v3, v4, v5, v6, v7;
    asm volatile("ds_read_b32 %0, %8\n\tds_read_b32 %1, %8 offset:256\n\tds_read_b32 %2, %8 offset:512\n\tds_read_b32 %3, %8 offset:768\n\t"
                 "ds_read_b32 %4, %8 offset:1040\n\tds_read_b32 %5, %8 offset:1296\n\tds_read_b32 %6, %8 offset:1552\n\tds_read_b32 %7, %8 offset:1808\n\ts_waitcnt lgkmcnt(0)"
                 : "=&v"(v0), "=&v"(v1), "=&v"(v2), "=&v"(v3), "=&v"(v4), "=&v"(v5), "=&v"(v6), "=&v"(v7) : "v"(a) : "memory");
    const u32x4 w4 = {pk2(v0, v1), pk2(v2, v3), pk2(v4, v5), pk2(v6, v7)};
    bf16_t* dst = (bf16_t*)(((unsigned long long)e0[3] << 32) | e0[2]);
    *(__attribute__((address_space(1))) u32x4*)(dst + (size_t)((unsigned)nl * e1[1]) + kc * 8) = w4;
}
DEVI int cride_boff(int j) { return CB_OFF + (j & 1) * CB_BUF; }
DEVI void cride_step(lchar* lds, ConvRide& cr) {
    const bool cnew = cr.j < cr.nj;
    if (cnew) cride_issue(lds, cr.j, cride_boff(cr.j));
    if (cr.pend >= 0) cride_consume(lds, cr.pend, cride_boff(cr.pend));
    cr.pend = cnew ? cr.j : -1; cr.j += cnew ? 1 : 0;
}

typedef short v4i16 __attribute__((ext_vector_type(4)));
template <int MODE>
DEVI void attn_unit(lchar* lds, const Params& p, int l, int b, int h, int qi, bool ctxq, ConvRide& cr) {
    constexpr int TK = 128, NKB = TK / 16, NKK = TK / 32, NCT = CTXL / TK;
    constexpr int DK = MODE == 1 ? 96 : 64, QG = 2, KS = DK * 2 + 16, VS = 144, NKS = DK / 32;
    constexpr int NSLOT = 3, KMB = TK * 128, KRB = MODE == 1 ? TK * 64 : 0, VBY = TK * 128, SLOT = KMB + KRB + VBY, OFFB = NSLOT * SLOT;
    constexpr int NLD = MODE == 1 ? 5 : 4;
    static_assert(OFFB + 2048 <= CB_OFF, "attention LDS ring");
    const int tid = ltid(), wid = tid >> 6, lane = tid & 63, fr = lane & 15, fq = lane >> 4;
    const bf16_t* P = (const bf16_t*)(p.ws + OFF_P);
    const bf16_t* KVB = (const bf16_t*)(p.ws + OFF_KVB);
    const int qcol = MODE == 0 ? PC_AQ + h * 64 : MODE == 1 ? PC_BQN + h * 64 : MODE == 2 ? PC_CQ + h * 64 : PC_DQ + h * 64;
    const int kcol = MODE == 0 ? PC_AK + (h >> 1) * 64 : MODE == 2 ? PC_CK + (h >> 1) * 64 : PC_DK + h * 64;
    const int vcol = MODE == 0 ? PC_AV + (h >> 1) * 64 : MODE == 2 ? PC_CV + (h >> 1) * 64 : PC_DV + h * 64;
    const int ocol = MODE * 256 + h * 64;
    const int qrow0 = (ctxq ? T_LAT + b * CTXL : b * SEQ) + qi * (NW * QG * 16) + wid * (QG * 16);
    bf16x8 qf[QG][NKS];
#pragma unroll
    for (int g = 0; g < QG; ++g)
#pragma unroll
        for (int ks = 0; ks < NKS; ++ks) {
            const size_t row = (size_t)(qrow0 + g * 16 + fr);
            const bf16_t* ptr = (MODE == 1 && ks == 2) ? P + row * NP + PC_BQR + h * 32 + fq * 8 : P + row * NP + qcol + ks * 32 + fq * 8;
            qf[g][ks] = *(const bf16x8*)ptr;
        }
    int nlat = 0, lat0 = 0, rs = 0;
    if (!ctxq) {
        if (MODE == 0 || MODE == 1) { nlat = SEQ / TK; lat0 = 0; }
        else if (MODE == 2) { const int k0 = max(0, qi * 256 - 128), k1 = min(SEQ, qi * 256 + 384); nlat = (k1 - k0) / TK; lat0 = k0; }
        else { rs = min(max(4 * qi - 4, 0), 24); const int rs3 = min(max(4 * qi + 3 - 4, 0), 24); nlat = (rs3 + 8 - rs + 1) >> 1; lat0 = rs * 64; }
    }
    const int ntile = NCT + nlat;
    LAS float* btab = (LAS float*)(lds + OFFB);
    if (MODE == 3) { const float* rpb = p.d_rpb + (size_t)(l * 4 + h) * 465; for (int i = tid; i < 465; i += NT) btab[i] = rpb[i] * LOG2E; }
    constexpr float THR = 8.f;
    float mref[QG]; f32x4 o[QG][4], ol[QG];
#pragma unroll
    for (int g = 0; g < QG; ++g) {
        mref[g] = 0.f; ol[g] = (f32x4){0.f, 0.f, 0.f, 0.f};
        if (MODE == 2) { mref[g] = p.c_sink[l * 4 + h] * LOG2E; ol[g][0] = fq == 0 ? 1.f : 0.f; }
#pragma unroll
        for (int d = 0; d < 4; ++d) o[g][d] = (f32x4){0.f, 0.f, 0.f, 0.f};
    }
    const unsigned onesw = fr == 0 ? 0x3F803F80u : 0u;
    const bf16x8 vones = __builtin_bit_cast(bf16x8, (u32x4){onesw, onesw, onesw, onesw});
    auto tile_row = [&](int t) { return t < NCT ? T_LAT + b * CTXL + t * TK : b * SEQ + lat0 + (t - NCT) * TK; };
    unsigned goff[2], groff = 0;
    constexpr unsigned PITCH = MODE == 1 ? NKV * 2 : NP * 2;
#pragma unroll
    for (int i = 0; i < 2; ++i) { const int bb = i * 8192 + tid * 16, r = bb >> 7, c = ((bb >> 4) & 7) ^ (r & 7); goff[i] = (unsigned)r * PITCH + (unsigned)c * 16u; }
    if (MODE == 1) { const int bb = tid * 16, r = bb >> 6, c = ((bb >> 4) & 3) ^ ((r ^ (r >> 2)) & 3); groff = (unsigned)r * (NP * 2) + (unsigned)c * 16u; }
    const char* kbase0 = MODE == 1 ? (const char*)KVB + h * 256 : (const char*)P + kcol * 2;
    const char* vbase0 = MODE == 1 ? (const char*)KVB + h * 256 + 128 : (const char*)P + vcol * 2;
    const unsigned ldsw = (unsigned)__builtin_amdgcn_readfirstlane(wid) * 1024u;
#define ATT_GLDS(src, dst) __builtin_amdgcn_global_load_lds((const __attribute__((address_space(1))) unsigned*)(src), (LAS unsigned*)(dst), 16, 0, 0)
    auto issue_tile = [&](int t, auto slc) {
        constexpr int slot = decltype(slc)::value;
        const size_t r0 = (size_t)tile_row(t);
        const char* kb_ = kbase0 + r0 * PITCH; const char* vb_ = vbase0 + r0 * PITCH;
        lchar* sl = lds + slot * SLOT + ldsw;
#pragma unroll
        for (int i = 0; i < 2; ++i) ATT_GLDS(kb_ + goff[i], sl + i * 8192);
        if (MODE == 1) ATT_GLDS((const char*)P + (r0 * NP + PC_BKR) * 2 + groff, sl + KMB);
#pragma unroll
        for (int i = 0; i < 2; ++i) ATT_GLDS(vb_ + goff[i], sl + KMB + KRB + i * 8192);
    };
    const int kq7 = fr & 7;
    const int koffm = fr * 128;
    const int koffr = KMB + fr * 64 + ((fq ^ ((fr ^ (fr >> 2)) & 3)) << 4);
    const int vrow = 4 * fq + (fr >> 2), v7 = vrow & 7;
    const int voffb = KMB + KRB + vrow * 128 + (fr & 1) * 8;
    typedef std::integral_constant<int, 0> SL0; typedef std::integral_constant<int, 1> SL1; typedef std::integral_constant<int, 2> SL2;
    issue_tile(0, SL0{});
    if (ntile > 1) issue_tile(1, SL1{});
    auto step = [&](int t, auto slc, auto isc) {
        constexpr int slot = decltype(slc)::value;
        if (t + 1 < ntile) { if (MODE == 1) asm volatile("s_waitcnt vmcnt(5) lgkmcnt(0)" ::: "memory"); else asm volatile("s_waitcnt vmcnt(4) lgkmcnt(0)" ::: "memory"); }
        else asm volatile("s_waitcnt vmcnt(0) lgkmcnt(0)" ::: "memory");
        __builtin_amdgcn_s_barrier();
        asm volatile("" ::: "memory");
        cride_step(lds, cr);
        const lchar* Sb = lds + slot * SLOT;
        f32x4 s[QG][NKB];
#pragma unroll
        for (int g = 0; g < QG; ++g)
#pragma unroll
            for (int kb = 0; kb < NKB; ++kb) s[g][kb] = (f32x4){-mref[g], -mref[g], -mref[g], -mref[g]};
#pragma unroll
        for (int kb = 0; kb < NKB; ++kb)
#pragma unroll
            for (int ks = 0; ks < NKS; ++ks) {
                const bf16x8 kf = (MODE == 1 && ks == 2) ? *(const LAS bf16x8*)(Sb + koffr + kb * 1024) : *(const LAS bf16x8*)(Sb + koffm + kb * 2048 + (((ks * 4 + fq) ^ kq7) << 4));
#pragma unroll
                for (int g = 0; g < QG; ++g) s[g][kb] = __builtin_amdgcn_mfma_f32_16x16x32_bf16(kf, qf[g][ks], s[g][kb], 0, 0, 0);
            }
        if (t >= NCT) {
            if (MODE == 2) {
                const int k0t = lat0 + (t - NCT) * TK;
#pragma unroll
                for (int g = 0; g < QG; ++g) { const int qpos = qi * 256 + wid * 32 + g * 16 + fr;
#pragma unroll
                    for (int kb = 0; kb < NKB; ++kb)
#pragma unroll
                        for (int j = 0; j < 4; ++j) { const int d = qpos - (k0t + kb * 16 + fq * 4 + j); if (d > 128 || d < -128) s[g][kb][j] = -1e30f; } }
            }
            if (MODE == 3) {
                const int myr = 4 * qi + (wid >> 1), myrs = min(max(myr - 4, 0), 24);
#pragma unroll
                for (int g = 0; g < QG; ++g) {
                    const int c = (wid & 1) * 32 + g * 16 + fr, cs = min(max(c - 8, 0), 48);
#pragma unroll
                    for (int kb = 0; kb < NKB; ++kb) {
                        const int krow = rs + 2 * (t - NCT) + (kb >> 2);
                        const bool rowok = (unsigned)(krow - myrs) < 8u;
                        const int brow = (krow - myr + 7) * 31;
#pragma unroll
                        for (int j = 0; j < 4; ++j) { const int kc = (kb & 3) * 16 + fq * 4 + j; const bool ok = rowok && (unsigned)(kc - cs) < 16u;
                            const float bv = btab[ok ? brow + kc - c + 15 : 0];
                            s[g][kb][j] = ok ? s[g][kb][j] + bv : -1e30f; }
                    }
                }
            }
        }
        bf16x8 pf[QG][NKK];
#pragma unroll
        for (int g = 0; g < QG; ++g) {
            float mx = s[g][0][0];
#pragma unroll
            for (int kb = 0; kb < NKB; ++kb)
#pragma unroll
                for (int j = 0; j < 4; ++j) mx = fmaxf(mx, s[g][kb][j]);
            mx = rows_max(mx);
            const bool first = MODE != 2 && t == 0;
            if (first || __any(mx > THR)) {
                const float d = first ? mx : fmaxf(mx, 0.f), alpha = fexp2(-d);
                mref[g] += d;
#pragma unroll
                for (int kb = 0; kb < NKB; ++kb)
#pragma unroll
                    for (int j = 0; j < 4; ++j) s[g][kb][j] -= d;
#pragma unroll
                for (int dd = 0; dd < 4; ++dd) o[g][dd] *= alpha;
                ol[g] *= alpha;
            }
#pragma unroll
            for (int kb = 0; kb < NKB; ++kb)
#pragma unroll
                for (int j = 0; j < 4; ++j) s[g][kb][j] = fexp2(s[g][kb][j]);
#pragma unroll
            for (int kk = 0; kk < NKK; ++kk) {
                const unsigned w0 = pk2(s[g][2 * kk][0], s[g][2 * kk][1]), w1 = pk2(s[g][2 * kk][2], s[g][2 * kk][3]);
                const unsigned w2 = pk2(s[g][2 * kk + 1][0], s[g][2 * kk + 1][1]), w3 = pk2(s[g][2 * kk + 1][2], s[g][2 * kk + 1][3]);
                const u32x4 w = {w0, w1, w2, w3};
                pf[g][kk] = __builtin_bit_cast(bf16x8, w);
            }
        }
        __builtin_amdgcn_sched_barrier(0);
        if (t + 2 < ntile) issue_tile(t + 2, isc);
        __builtin_amdgcn_sched_barrier(0);
        v4i16 vlo[2][NKK], vhi[2][NKK];
#define ATT_VREAD(db_, buf_) do { const unsigned vaddr = (unsigned)(__UINTPTR_TYPE__)(Sb + voffb + ((((db_) * 2 + ((fr & 3) >> 1)) ^ v7) << 4)); \
            _Pragma("unroll") for (int kk = 0; kk < NKK; ++kk) { \
                asm volatile("ds_read_b64_tr_b16 %0, %1 offset:%2" : "=v"(vlo[buf_][kk]) : "v"(vaddr), "i"(kk * 4096)); \
                asm volatile("ds_read_b64_tr_b16 %0, %1 offset:%2" : "=v"(vhi[buf_][kk]) : "v"(vaddr), "i"(kk * 4096 + 2048)); } } while (0)
        ATT_VREAD(0, 0);
#pragma unroll
        for (int db = 0; db < 4; ++db) {
            if (db < 3) { ATT_VREAD(db + 1, (db + 1) & 1); asm volatile("s_waitcnt lgkmcnt(%0)" :: "i"(2 * NKK) : "memory"); }
            else asm volatile("s_waitcnt lgkmcnt(0)" ::: "memory");
            __builtin_amdgcn_sched_barrier(0);
#pragma unroll
            for (int kk = 0; kk < NKK; ++kk) {
                const bf16x8 vf = __builtin_shufflevector(vlo[db & 1][kk], vhi[db & 1][kk], 0, 1, 2, 3, 4, 5, 6, 7);
#pragma unroll
                for (int g = 0; g < QG; ++g) o[g][db] = __builtin_amdgcn_mfma_f32_16x16x32_bf16(vf, pf[g][kk], o[g][db], 0, 0, 0);
            }
            __builtin_amdgcn_sched_barrier(0);
        }
#undef ATT_VREAD
#pragma unroll
        for (int kk = 0; kk < NKK; ++kk)
#pragma unroll
            for (int g = 0; g < QG; ++g) ol[g] = __builtin_amdgcn_mfma_f32_16x16x32_bf16(vones, pf[g][kk], ol[g], 0, 0, 0);
    };
    for (int t = 0; t < ntile; t += 3) {
        step(t, SL0{}, SL2{});
        if (t + 1 < ntile) step(t + 1, SL1{}, SL0{});
        if (t + 2 < ntile) step(t + 2, SL2{}, SL1{});
    }
#undef ATT_GLDS
    asm volatile("s_waitcnt lgkmcnt(0)" ::: "memory");
    __builtin_amdgcn_s_barrier();
    bf16_t* O = (bf16_t*)(p.ws + OFF_MIXIN);
#pragma unroll
    for (int g = 0; g < QG; ++g) {
        float lt = rows_sum(fq == 0 ? ol[g][0] : 0.f);
        const float inv = 1.f / lt;
        const size_t row = (size_t)(qrow0 + g * 16 + fr);
#pragma unroll
        for (int d = 0; d < 4; ++d) {
            u32x2 v = {pk2(o[g][d][0] * inv, o[g][d][1] * inv), pk2(o[g][d][2] * inv, o[g][d][3] * inv)};
            *(u32x2*)(O + row * 1024 + ocol + d * 16 + fq * 4) = v;
        }
    }
}

DEVI void phase_s4(lchar* lds, const Params& p, int l) {
    const int G = gridDim.x, bid = blockIdx.x;
    const int ctotal = bid < NCHUNK ? (NCHUNK - bid + G - 1) / G : 0;
    ConvRide cr; cr.j = 0; cr.pend = -1; cr.nj = min(ctotal, CD_MAX);
    cride_table(lds, p, l, 0, cr.nj);
    const int nc3 = l == 0 ? 32 : 0;
    for (int u = bid; u < 256 + nc3; u += G) { const bool cq = u >= 256; const int v = cq ? u - 256 : u; attn_unit<0>(lds, p, l, v & 7, (v >> 3) & 3, v >> 5, cq, cr); }
    for (int u = bid; u < 256 + nc3; u += G) { const bool cq = u >= 256; const int v = cq ? u - 256 : u; attn_unit<1>(lds, p, l, v & 7, (v >> 3) & 3, v >> 5, cq, cr); }
    for (int u = bid; u < 256 + nc3; u += G) { const bool cq = u >= 256; const int v = cq ? u - 256 : u; attn_unit<2>(lds, p, l, v & 7, (v >> 3) & 3, v >> 5, cq, cr); }
    for (int u = bid; u < 256 + nc3; u += G) { const bool cq = u >= 256; const int v = cq ? u - 256 : u; attn_unit<3>(lds, p, l, v & 7, (v >> 3) & 3, v >> 5, cq, cr); }
    asm volatile("s_waitcnt vmcnt(0) lgkmcnt(0)" ::: "memory");
    __builtin_amdgcn_s_barrier();
    if (cr.pend >= 0) cride_consume(lds, cr.pend, cride_boff(cr.pend));
    for (int base = 0;;) {
        while (cr.j < cr.nj) {
            const int n = min(cr.nj - cr.j, 6);
            for (int i = 0; i < n; ++i) cride_issue(lds, cr.j + i, i * CB_BUF);
            asm volatile("s_waitcnt vmcnt(0) lgkmcnt(0)" ::: "memory");
            __builtin_amdgcn_s_barrier();
            for (int i = 0; i < n; ++i) cride_consume(lds, cr.j + i, i * CB_BUF);
            cr.j += n;
            asm volatile("s_waitcnt lgkmcnt(0)" ::: "memory");
            __builtin_amdgcn_s_barrier();
        }
        base += CD_MAX; if (base >= ctotal) break;
        cr.j = 0; cr.nj = min(ctotal - base, CD_MAX);
        cride_table(lds, p, l, base, cr.nj);
    }
    asm volatile("s_waitcnt vmcnt(0) lgkmcnt(0)" ::: "memory");
    __syncthreads();
}

DEVI void phase_s6(lchar* lds, const Params& p, int l) {
    constexpr int RS = 2064, LO_OFF = 16 * RS;
    const int tid = ltid(), wid = tid >> 6, lane = tid & 63, fr = lane & 15, fq = lane >> 4, G = gridDim.x;
    const int ntile = (l == 0 ? T_ALL : T_LAT) / RT_TILE;
    LAS float* lg = (LAS float*)lds;
    LAS int* tot = (LAS int*)(lds + 8192);
    const bf16_t* MIX = (const bf16_t*)(p.ws + OFF_MIX);
    bf16_t* H = (bf16_t*)(p.ws + OFF_H);
    const float* pg = p.post_mix_g + l * 1024; const float* fg = p.pre_ffn_g + l * 1024;
    unsigned char* e8 = (unsigned char*)(p.ws + OFF_E8); float* w8 = (float*)(p.ws + OFF_W8); unsigned short* lr8 = (unsigned short*)(p.ws + OFF_LR8);
    int* hist = (int*)(p.ws + OFF_HIST);
    const float rbias = p.router_b[l * 64 + lane];
    const u32x4* wt = (const u32x4*)(p.ws + OFF_WRT) + ((size_t)((l * 4 + (wid & 3)) * 32 + (wid >> 2) * 16) * 2) * 64 + lane;
#define RT_LOADB(dst, b) do { const u32x4* wb_ = wt + (b) * 8 * 64; asm volatile("" : "+v"(wb_)); _Pragma("unroll") for (int i = 0; i < 8; ++i) dst[i] = wb_[i * 64]; } while (0)
    u32x2 mu[2][4]; float4 xv[2][4];
    bf16_t* XB = (bf16_t*)(p.ws + OFF_XB);
#define S6_LOAD(TILE) do { _Pragma("unroll") for (int r2 = 0; r2 < 2; ++r2) { const int r_ = (TILE) * RT_TILE + wid * 2 + r2; const float* xr = xrow_ptr(p, 0, r_); \
        _Pragma("unroll") for (int i = 0; i < 4; ++i) { mu[r2][i] = *(const u32x2*)(MIX + (size_t)r_ * 1024 + i * 256 + lane * 4); \
            if (l == 0) xv[r2][i] = *(const float4*)(xr + i * 256 + lane * 4); \
            else { const u32x2 t_ = *(const u32x2*)(XB + (size_t)r_ * 1024 + i * 256 + lane * 4); xv[r2][i].x = __uint_as_float(t_[0]); xv[r2][i].y = __uint_as_float(t_[1]); } } } } while (0)
    if ((int)blockIdx.x < ntile) S6_LOAD(blockIdx.x);
    for (int tile = blockIdx.x; tile < ntile; tile += G) {
        {
            const int r0 = tile * RT_TILE + wid * 2;
            const int bb = r0 < T_LAT ? (r0 >> 11) : 8;
            const float* mod = (const float*)(p.ws + OFF_MOD) + ((size_t)l * 9 + bb) * 6144;
            float4 gg[4], g1[4], fgv[4], sh[4], sc[4];
#pragma unroll
            for (int i = 0; i < 4; ++i) { const int c = i * 256 + lane * 4;
                gg[i] = *(const float4*)(pg + c); g1[i] = *(const float4*)(mod + 2048 + c); fgv[i] = *(const float4*)(fg + c);
                sh[i] = *(const float4*)(mod + 3072 + c); sc[i] = *(const float4*)(mod + 4096 + c); }
#pragma unroll
            for (int r2 = 0; r2 < 2; ++r2) {
                const int r = r0 + r2;
                float mv[16]; float ss = 0.f;
#pragma unroll
                for (int i = 0; i < 4; ++i) { mv[i * 4 + 0] = bflo(mu[r2][i][0]); mv[i * 4 + 1] = bfhi(mu[r2][i][0]); mv[i * 4 + 2] = bflo(mu[r2][i][1]); mv[i * 4 + 3] = bfhi(mu[r2][i][1]); }
#pragma unroll
                for (int i = 0; i < 16; ++i) ss += mv[i] * mv[i];
                ss = wave_sum(ss);
                const float rs1 = rsqrtf(ss * (1.f / 1024.f) + EPS);
                float x1[16]; float s2 = 0.f;
#pragma unroll
                for (int i = 0; i < 4; ++i) {
                    float4 xx = xv[r2][i];
                    if (l != 0) { const unsigned u0 = __float_as_uint(xx.x), u1 = __float_as_uint(xx.y); xx = make_float4(bflo(u0), bfhi(u0), bflo(u1), bfhi(u1)); }
                    x1[i * 4 + 0] = xx.x + g1[i].x * (mv[i * 4 + 0] * rs1 * gg[i].x); x1[i * 4 + 1] = xx.y + g1[i].y * (mv[i * 4 + 1] * rs1 * gg[i].y);
                    x1[i * 4 + 2] = xx.z + g1[i].z * (mv[i * 4 + 2] * rs1 * gg[i].z); x1[i * 4 + 3] = xx.w + g1[i].w * (mv[i * 4 + 3] * rs1 * gg[i].w);
                    *(u32x2*)(XB + (size_t)r * 1024 + i * 256 + lane * 4) = (u32x2){pk2(x1[i * 4 + 0], x1[i * 4 + 1]), pk2(x1[i * 4 + 2], x1[i * 4 + 3])};
                }
#pragma unroll
                for (int i = 0; i < 16; ++i) s2 += x1[i] * x1[i];
                s2 = wave_sum(s2);
                const float rs2 = rsqrtf(s2 * (1.f / 1024.f) + EPS);
#pragma unroll
                for (int i = 0; i < 4; ++i) {
                    const int c = i * 256 + lane * 4;
                    const float a0 = x1[i * 4 + 0] * rs2 * fgv[i].x * (1.f + sc[i].x) + sh[i].x, a1 = x1[i * 4 + 1] * rs2 * fgv[i].y * (1.f + sc[i].y) + sh[i].y;
                    const float a2 = x1[i * 4 + 2] * rs2 * fgv[i].z * (1.f + sc[i].z) + sh[i].z, a3 = x1[i * 4 + 3] * rs2 * fgv[i].w * (1.f + sc[i].w) + sh[i].w;
                    const unsigned h0 = pk2(a0, a1), h1 = pk2(a2, a3);
                    *(u32x2*)(H + (size_t)r * 1024 + c) = (u32x2){h0, h1};
                    *(LAS u32x2*)(lds + (wid * 2 + r2) * RS + c * 2) = (u32x2){h0, h1};
                    *(LAS u32x2*)(lds + LO_OFF + (wid * 2 + r2) * RS + c * 2) = (u32x2){pk2(a0 - bflo(h0), a1 - bfhi(h0)), pk2(a2 - bflo(h1), a3 - bfhi(h1))};
                }
            }
        }
        u32x4 bA[8], bB[8];
        __builtin_amdgcn_sched_barrier(0);
        RT_LOADB(bA, 0); RT_LOADB(bB, 1);
        __builtin_amdgcn_sched_barrier(0);
        __syncthreads();
        f32x4 acc0 = {0.f, 0.f, 0.f, 0.f}, acc1 = {0.f, 0.f, 0.f, 0.f}, acc2 = {0.f, 0.f, 0.f, 0.f};
        const lchar* ha = lds + fr * RS + ((wid >> 2) * 512 + fq * 8) * 2;
#define RT_MMA(src, b) do { _Pragma("unroll") for (int i = 0; i < 4; ++i) { const bf16x8 ah = *(const LAS bf16x8*)(ha + ((b) * 4 + i) * 64), al = *(const LAS bf16x8*)(ha + LO_OFF + ((b) * 4 + i) * 64); \
            const bf16x8 wh = __builtin_bit_cast(bf16x8, src[2 * i]), wl = __builtin_bit_cast(bf16x8, src[2 * i + 1]); \
            acc0 = __builtin_amdgcn_mfma_f32_16x16x32_bf16(ah, wh, acc0, 0, 0, 0); acc1 = __builtin_amdgcn_mfma_f32_16x16x32_bf16(ah, wl, acc1, 0, 0, 0); \
            acc2 = __builtin_amdgcn_mfma_f32_16x16x32_bf16(al, wh, acc2, 0, 0, 0); } } while (0)
        RT_MMA(bA, 0); __builtin_amdgcn_sched_barrier(0);
        RT_LOADB(bA, 2); __builtin_amdgcn_sched_barrier(0);
        RT_MMA(bB, 1); __builtin_amdgcn_sched_barrier(0);
        RT_LOADB(bB, 3);
        if (tile + G < ntile) S6_LOAD(tile + G);
        __builtin_amdgcn_sched_barrier(0);
        RT_MMA(bA, 2);
        RT_MMA(bB, 3);
        __syncthreads();
#pragma unroll
        for (int j = 0; j < 4; ++j) lg[((wid >> 2) * 16 + fq * 4 + j) * 64 + (wid & 3) * 16 + fr] = acc0[j] + (acc1[j] + acc2[j]);
        __syncthreads();
        int cntw = 0; bool sel[2]; int jj[2], lrw[2]; float ww[2];
#pragma unroll
        for (int t = 0; t < 2; ++t) {
            const float lgt = lg[(wid * 2 + t) * 64 + lane] + lg[(16 + wid * 2 + t) * 64 + lane];
            const float sg = __frcp_rn(1.f + __expf(-lgt)), sb = sg + rbias;
            const float m1 = gmax8(sb);
            const unsigned long long eqm = __ballot(sb == m1);
            const int gbase = lane & ~7;
            const unsigned gm = (unsigned)(eqm >> gbase) & 0xffu;
            const int am = gbase + __ffs(gm) - 1;
            const float m2 = gmax8(lane == am ? -INFINITY : sb);
            const float gs = m1 + m2;
            const int myg = lane >> 3; int grank = 0;
#pragma unroll
            for (int g2 = 0; g2 < 8; ++g2) { const float ov = __int_as_float(__builtin_amdgcn_readlane(__float_as_int(gs), g2 * 8)); grank += (ov > gs || (ov == gs && g2 < myg)) ? 1 : 0; }
            const bool gsel = grank < 4;
            const float v = gsel ? sb : -INFINITY;
            float vv = v; bool picked = false;
#pragma unroll
            for (int r8 = 0; r8 < 8; ++r8) {
                const float mx = wave_max_dpp(vv);
                const unsigned long long eq = __ballot(vv == mx);
                const int first = (int)__ffsll((long long)eq) - 1;
                if (lane == first) { picked = true; vv = -INFINITY; }
            }
            sel[t] = picked;
            const float wsum = wave_sum_dpp(sel[t] ? sg : 0.f);
            const unsigned long long sm = __ballot(sel[t]);
            jj[t] = __popcll(sm & ((1ull << lane) - 1ull));
            ww[t] = sg / wsum * 2.5f;
            lrw[t] = cntw; cntw += sel[t] ? 1 : 0;
        }
        tot[wid * 64 + lane] = cntw;
        __syncthreads();
        int base = 0, total = 0;
#pragma unroll
        for (int w = 0; w < NW; ++w) { const int c = tot[w * 64 + lane]; base += w < wid ? c : 0; total += c; }
        if (wid == 0) hist[tile * 64 + lane] = total;
#pragma unroll
        for (int t = 0; t < 2; ++t) if (sel[t]) {
            const size_t idx = (size_t)(tile * RT_TILE + wid * 2 + t) * 8 + jj[t];
            e8[idx] = (unsigned char)lane; w8[idx] = ww[t]; lr8[idx] = (unsigned short)(base + lrw[t]);
        }
        __syncthreads();
    }
#undef S6_LOAD
#undef RT_LOADB
#undef RT_MMA
}

DEVI void phase_s7(const Params& p, int l) {
    const int wid = ltid() >> 6, lane = ltid() & 63, gw = blockIdx.x * NW + wid;
    if (gw >= 64) return;
    constexpr int PER = (MAX_RT + 63) / 64;
    const int ntile = (l == 0 ? T_ALL : T_LAT) / RT_TILE, e = gw;
    const int* hist = (const int*)(p.ws + OFF_HIST); int* toff = (int*)(p.ws + OFF_TOFF); int* cnt = (int*)(p.ws + OFF_CNT);
    int h[PER]; int sum = 0;
#pragma unroll
    for (int i = 0; i < PER; ++i) { const int tt = lane * PER + i; h[i] = tt < ntile ? hist[tt * 64 + e] : 0; }
#pragma unroll
    for (int i = 0; i < PER; ++i) sum += h[i];
    int inc = 0;
#pragma unroll
    for (int j = 0; j < 64; ++j) { const int sj = __builtin_amdgcn_readlane(sum, j); if (lane >= j) inc += sj; }
    int run = inc - sum;
#pragma unroll
    for (int i = 0; i < PER; ++i) { const int tt = lane * PER + i; if (tt < ntile) toff[tt * 64 + e] = run; run += h[i]; }
    if (lane == 63) cnt[e] = inc;
}

DEVI void phase_s8(lchar* lds, const Params& p, int l) {
    build_seg(lds, p);
    LAS int* seg = (LAS int*)(lds + SEG_OFF);
    const int ntok = l == 0 ? T_ALL : T_LAT, n = ntok * 8;
    const unsigned char* e8 = (const unsigned char*)(p.ws + OFF_E8); const unsigned short* lr8 = (const unsigned short*)(p.ws + OFF_LR8);
    const int* toff = (const int*)(p.ws + OFF_TOFF); const int* cnt = (const int*)(p.ws + OFF_CNT);
    int* stk = (int*)(p.ws + OFF_STK); int* tsl = (int*)(p.ws + OFF_TSL);
    const int step8 = gridDim.x * NT;
    for (int i0 = blockIdx.x * NT + ltid(); i0 < n; i0 += 2 * step8) {
        const int i1 = i0 + step8; const bool two = i1 < n;
        const int e0 = e8[i0], r0 = lr8[i0], e1 = two ? e8[i1] : 0, r1 = two ? lr8[i1] : 0;
        const int o0 = toff[((i0 >> 3) / RT_TILE) * 64 + e0], o1 = two ? toff[((i1 >> 3) / RT_TILE) * 64 + e1] : 0;
        const int s0 = seg[e0] + o0 + r0, s1 = seg[e1] + o1 + r1;
        stk[s0] = i0 >> 3; tsl[i0] = s0;
        if (two) { stk[s1] = i1 >> 3; tsl[i1] = s1; }
    }
    for (int e = blockIdx.x; e < 64; e += gridDim.x) { const int s0 = seg[e] + cnt[e], s1 = seg[e + 1]; for (int s = s0 + ltid(); s < s1; s += NT) stk[s] = 0; }
}

DEVI void phase_s11(const Params& p, int l, bool do_store = true) {
    static_assert(Y8_ALL, "the combine reads fp8 rows");
    const int wid = ltid() >> 6, lane = ltid() & 63, gw = blockIdx.x * NW + wid, nw = gridDim.x * NW;
    const int ntok = l == 0 ? T_ALL : T_LAT;
    const int* tsl = (const int*)(p.ws + OFF_TSL); const float* w8 = (const float*)(p.ws + OFF_W8);
    const unsigned char* Y8 = (const unsigned char*)(p.ws + OFF_Y); const bf16_t* YS = (const bf16_t*)(p.ws + OFF_H);
    bf16_t* XBp = (bf16_t*)(p.ws + OFF_XB);
    const float* pg = p.post_ffn_g + l * 1024;
    for (int t0 = gw; t0 < ntok; t0 += 2 * nw) {
        const int t1 = t0 + nw; const bool two = t1 < ntok;
        int slot[2]; float wv[2];
        slot[0] = tsl[(size_t)t0 * 8 + (lane & 7)]; wv[0] = w8[(size_t)t0 * 8 + (lane & 7)];
        slot[1] = 0; wv[1] = 0.f;
        if (two) { slot[1] = tsl[(size_t)t1 * 8 + (lane & 7)]; wv[1] = w8[(size_t)t1 * 8 + (lane & 7)]; }
        u32x2 yv[2][8][2]; u32x4 ys[2][2], xr[2][2];
#pragma unroll
        for (int u = 0; u < 2; ++u) if (u == 0 || two) {
            const int t = u ? t1 : t0;
#pragma unroll
            for (int j = 0; j < 8; ++j) { const unsigned char* row8 = Y8 + (size_t)__builtin_amdgcn_readlane(slot[u], j) * 1024;
#pragma unroll
                for (int i = 0; i < 2; ++i) yv[u][j][i] = *(const u32x2*)(row8 + (lane + 64 * i) * 8); }
#pragma unroll
            for (int i = 0; i < 2; ++i) { ys[u][i] = *(const u32x4*)(YS + (size_t)t * 1024 + (lane + 64 * i) * 8); xr[u][i] = *(const u32x4*)(XBp + (size_t)t * 1024 + (lane + 64 * i) * 8); }
        }
        __builtin_amdgcn_sched_barrier(0);
#pragma unroll
        for (int u = 0; u < 2; ++u) if (u == 0 || two) {
            const int t = u ? t1 : t0;
            float f[16];
#pragma unroll
            for (int i = 0; i < 16; ++i) f[i] = 0.f;
#pragma unroll
            for (int j = 0; j < 8; ++j) {
                const float wq = __int_as_float(__builtin_amdgcn_readlane(__float_as_int(wv[u]), j)) * (1.f / 64.f);
#pragma unroll
                for (int i = 0; i < 2; ++i)
#pragma unroll
                    for (int q = 0; q < 2; ++q) { const f32x2 lo = __builtin_amdgcn_cvt_pk_f32_fp8((int)yv[u][j][i][q], false), hi = __builtin_amdgcn_cvt_pk_f32_fp8((int)yv[u][j][i][q], true);
                        f[i * 8 + 4 * q + 0] += wq * lo[0]; f[i * 8 + 4 * q + 1] += wq * lo[1]; f[i * 8 + 4 * q + 2] += wq * hi[0]; f[i * 8 + 4 * q + 3] += wq * hi[1]; }
            }
#pragma unroll
            for (int i = 0; i < 2; ++i)
#pragma unroll
                for (int q = 0; q < 4; ++q) { f[i * 8 + 2 * q] += bflo(ys[u][i][q]); f[i * 8 + 2 * q + 1] += bfhi(ys[u][i][q]); }
            float ss = 0.f;
#pragma unroll
            for (int i = 0; i < 16; ++i) ss += f[i] * f[i];
            ss = wave_sum(ss);
            const float rs = rsqrtf(ss * (1.f / 1024.f) + EPS);
            const int bb = t < T_LAT ? (t >> 11) : 8;
            const float* g2 = (const float*)(p.ws + OFF_MOD) + ((size_t)l * 9 + bb) * 6144 + 5120;
            bf16_t* xb = XBp + (size_t)t * 1024;
#pragma unroll
            for (int i = 0; i < 2; ++i) {
#pragma unroll
                for (int hq = 0; hq < 2; ++hq) {
                    const int c = (lane + 64 * i) * 8 + hq * 4;
                    const float4 xv = make_float4(bflo(xr[u][i][hq * 2]), bfhi(xr[u][i][hq * 2]), bflo(xr[u][i][hq * 2 + 1]), bfhi(xr[u][i][hq * 2 + 1])), gg = *(const float4*)(pg + c), gv = *(const float4*)(g2 + c);
                    float4 r;
                    r.x = xv.x + gv.x * (f[i * 8 + hq * 4 + 0] * rs * gg.x); r.y = xv.y + gv.y * (f[i * 8 + hq * 4 + 1] * rs * gg.y);
                    r.z = xv.z + gv.z * (f[i * 8 + hq * 4 + 2] * rs * gg.z); r.w = xv.w + gv.w * (f[i * 8 + hq * 4 + 3] * rs * gg.w);
                    if (l + 1 == DEPTH) { if (do_store) *(float4*)(p.out + (size_t)t * 1024 + c) = r; else asm volatile("" :: "v"(r.x), "v"(r.y), "v"(r.z), "v"(r.w)); }
                    f[i * 8 + hq * 4 + 0] = r.x; f[i * 8 + hq * 4 + 1] = r.y; f[i * 8 + hq * 4 + 2] = r.z; f[i * 8 + hq * 4 + 3] = r.w;
                }
                if (l + 1 < DEPTH) {
                    const u32x4 w = {pk2(f[i * 8 + 0], f[i * 8 + 1]), pk2(f[i * 8 + 2], f[i * 8 + 3]), pk2(f[i * 8 + 4], f[i * 8 + 5]), pk2(f[i * 8 + 6], f[i * 8 + 7])};
                    if (do_store) *(u32x4*)(xb + (lane + 64 * i) * 8) = w; else asm volatile("" :: "v"(w[0]), "v"(w[1]), "v"(w[2]), "v"(w[3]));
                }
            }
            if (l + 1 < DEPTH) {
                float s2 = 0.f;
#pragma unroll
                for (int i = 0; i < 16; ++i) s2 += f[i] * f[i];
                s2 = wave_sum(s2);
                const float rs2 = rsqrtf(s2 * (1.f / 1024.f) + EPS);
                const float* md = (const float*)(p.ws + OFF_MOD) + ((size_t)(l + 1) * 9 + bb) * 6144;
                const float* gn = p.pre_mix_g + (l + 1) * 1024;
                bf16_t* H = (bf16_t*)(p.ws + OFF_H);
#pragma unroll
                for (int i = 0; i < 2; ++i) {
                    const int c = (lane + 64 * i) * 8;
                    const float4 ga = *(const float4*)(gn + c), gb = *(const float4*)(gn + c + 4), sha = *(const float4*)(md + c), shb = *(const float4*)(md + c + 4);
                    const float4 sca = *(const float4*)(md + 1024 + c), scb = *(const float4*)(md + 1024 + c + 4);
                    const float a0 = f[i * 8 + 0] * rs2 * ga.x * (1.f + sca.x) + sha.x, a1 = f[i * 8 + 1] * rs2 * ga.y * (1.f + sca.y) + sha.y;
                    const float a2 = f[i * 8 + 2] * rs2 * ga.z * (1.f + sca.z) + sha.z, a3 = f[i * 8 + 3] * rs2 * ga.w * (1.f + sca.w) + sha.w;
                    const float a4 = f[i * 8 + 4] * rs2 * gb.x * (1.f + scb.x) + shb.x, a5 = f[i * 8 + 5] * rs2 * gb.y * (1.f + scb.y) + shb.y;
                    const float a6 = f[i * 8 + 6] * rs2 * gb.z * (1.f + scb.z) + shb.z, a7 = f[i * 8 + 7] * rs2 * gb.w * (1.f + scb.w) + shb.w;
                    if (do_store) *(u32x4*)(H + (size_t)t * 1024 + c) = (u32x4){pk2(a0, a1), pk2(a2, a3), pk2(a4, a5), pk2(a6, a7)};
                }
            }
        }
    }
}

constexpr int N_PHASES = 1 + 2 * 11;
__global__ void __launch_bounds__(NT, 2) mega(Params p) {
    extern __shared__ __attribute__((aligned(16))) char smem[];
    lchar* lds = (lchar*)smem;
    const int G = gridDim.x, bid = blockIdx.x;
    const bool multi = p.ph_hi - p.ph_lo > 1;
    XcdBarrier bar;
    if (multi) {
        volatile LAS unsigned* xbw = (volatile LAS unsigned*)(lds + LDS_XB);
        if (threadIdx.x == 0) { xbw[0] = 0u; xbw[1] = 0u; xbw[2] = 0u; xbw[3] = 0u; }
        __syncthreads();
        bar = xcd_barrier_post((unsigned*)(p.ws + OFF_CTL), xbw);
    }
#ifndef AUDIT_MASK
#define AUDIT_MASK 0xfff
#endif
#define EN(j) (((AUDIT_MASK) >> (j)) & 1)
#ifndef REPEAT_MASK
#define REPEAT_MASK 0
#endif
#define NREP(j) ((((REPEAT_MASK) >> (j)) & 1) ? 2 : 1)
#define PH(k) (p.ph_lo <= (k) && (k) < p.ph_hi)
#ifdef PROBE_A
#define STAMP(i) do { if (bid == 0 && threadIdx.x == 0) ((unsigned long long*)(p.ws + OFF_CTL + 32768))[i] = __builtin_amdgcn_s_memrealtime(); } while (0)
#else
#define STAMP(i) do { } while (0)
#endif
#define SEAM(k) do { if (p.ph_lo <= (k) && (k) + 1 < p.ph_hi) { XcdBarrier bb_ = bar; asm volatile("" : "+s"(bb_.bar)); xcd_barrier(bb_); } STAMP((k) + 1); } while (0)
    STAMP(0);
    if (EN(0) && PH(0)) for (int rep = 0; rep < NREP(0); ++rep) { const Params q = ldp(); phase_s0(lds, q); }
#ifdef EXTRA_BARRIERS
    if (multi) for (int xb = 0; xb < EXTRA_BARRIERS; ++xb) { XcdBarrier bb_ = bar; asm volatile("" : "+s"(bb_.bar)); xcd_barrier(bb_); }
#endif
    SEAM(0);
    for (int l = 0; l < 2; ++l) {
        const int pb = 1 + l * 11;
        const int nmt_all = l == 0 ? T_ALL / 128 : T_LAT / 128;
        if (EN(1) && PH(pb + 0)) for (int rep = 0; rep < NREP(1); ++rep) { const Params q = ldp(); if (l == 0) phase_s1(q, l); }
        if (l == 0) SEAM(pb + 0);
        if (EN(2) && PH(pb + 1)) for (int rep = 0; rep < NREP(2); ++rep) { const Params q = ldp(); Inproj8 S{q, l, lds}; gemm8_phase(lds, S); }
        SEAM(pb + 1);
        if (EN(3) && PH(pb + 2)) for (int rep = 0; rep < NREP(3); ++rep) { const Params q = ldp(); Kvup8 S{q, l}; gemm8_phase(lds, S); }
        SEAM(pb + 2);
        if (EN(4) && PH(pb + 3)) for (int rep = 0; rep < NREP(4); ++rep) { const Params q = ldp(); phase_s4(lds, q, l); }
        SEAM(pb + 3);
        if (EN(5) && PH(pb + 4)) for (int rep = 0; rep < NREP(5); ++rep) { const Params q = ldp(); Outproj8 S{q, l, nmt_all / 2}; gemm8_phase(lds, S); }
        SEAM(pb + 4);
        if (EN(6) && PH(pb + 5)) for (int rep = 0; rep < ((l == 0 && 5 != 10) ? NREP(6) : 1); ++rep) { const Params q = ldp(); phase_s6(lds, q, l); }
        SEAM(pb + 5);
        if (EN(7) && PH(pb + 6)) for (int rep = 0; rep < NREP(7); ++rep) { const Params q = ldp(); phase_s7(q, l); }
        SEAM(pb + 6);
        if (EN(8) && PH(pb + 7)) for (int rep = 0; rep < NREP(8); ++rep) { const Params q = ldp(); phase_s8(lds, q, l); }
        SEAM(pb + 7);
        if (EN(9) && PH(pb + 8)) for (int rep = 0; rep < NREP(9); ++rep) { const Params q = ldp(); build_seg(lds, q); const int nmt_r = __builtin_amdgcn_readfirstlane(((LAS int*)(lds + SEG_OFF))[64]) >> 8; Gateup8 S{q, lds, nmt_r, nmt_all / 2}; build_goff(q, nmt_r, S); gemm8_phase(lds, S); }
        SEAM(pb + 8);
        if (EN(10) && PH(pb + 9)) for (int rep = 0; rep < NREP(10); ++rep) { const Params q = ldp(); build_seg(lds, q); const int nmt_r = __builtin_amdgcn_readfirstlane(((LAS int*)(lds + SEG_OFF))[64]) >> 8; Down8 S{q, lds, nmt_r, nmt_all / 2, Y8_ALL || l == DEPTH - 1}; gemm8_phase(lds, S); }
        SEAM(pb + 9);
        if (EN(11) && PH(pb + 10)) { const Params q = ldp(); if (NREP(11) == 2) phase_s11(q, l, p.ph_lo == 777); phase_s11(q, l); }
        SEAM(pb + 10);
    }
#ifdef PROBE_A
    __syncthreads();
    if (bid == 0 && threadIdx.x == 0) {
        const unsigned long long* ts = (const unsigned long long*)(p.ws + OFF_CTL + 32768);
        p.out[0] = 1000.f * (float)(ts[PROBE_B] - ts[PROBE_A]) * 0.01f;
    }
#endif
}

extern "C" void kernel_launch(void* const* d_in, const int* in_sizes, int n_in, void* d_out, int out_size, void* d_ws, size_t ws_size, hipStream_t stream) {
    if (n_in < 26 || ws_size < WS_NEED) { fprintf(stderr, "kernel_launch: bad arguments (n_in %d, ws %zu < %zu)\n", n_in, ws_size, (size_t)WS_NEED); return; }
    Params p{};
    const float** pp = (const float**)&p;
    for (int i = 0; i < 26; ++i) pp[i] = (const float*)d_in[i];
    p.out = (float*)d_out; p.ws = (char*)d_ws;
    static int grid = 0;
    if (!grid) {
        int dev = 0, cus = 0, per_cu = 0;
        (void)hipGetDevice(&dev);
        (void)hipDeviceGetAttribute(&cus, hipDeviceAttributeMultiprocessorCount, dev);
        (void)hipFuncSetAttribute((const void*)mega, hipFuncAttributeMaxDynamicSharedMemorySize, LDS_BYTES);
        (void)hipOccupancyMaxActiveBlocksPerMultiprocessor(&per_cu, mega, NT, LDS_BYTES);
        grid = per_cu >= 1 ? cus : 0;
    }
    (void)hipMemsetAsync((char*)d_ws + OFF_CTL, 0, CTL_BYTES, stream);
#if ONE_LAUNCH
    p.ph_lo = 0; p.ph_hi = N_PHASES;
    if (grid > 0) hipLaunchKernelGGL(mega, dim3(grid), dim3(NT), LDS_BYTES, stream, p);
#else
    for (int k = 0; k < N_PHASES; ++k) { p.ph_lo = k; p.ph_hi = k + 1; hipLaunchKernelGGL(mega, dim3(grid), dim3(NT), LDS_BYTES, stream, p); }
#endif
}
```

```cpp
#include <hip/hip_runtime.h>
#include <stdint.h>
#include <stdio.h>
#include <string.h>
#include <type_traits>

#ifndef ONE_LAUNCH
#define ONE_LAUNCH 1
#endif

#ifndef Y8_ALL
#define Y8_ALL 1
#endif
#define DEVI __device__ __forceinline__
#define LAS __attribute__((address_space(3)))

typedef unsigned short bf16_t;
typedef short bf16x8 __attribute__((ext_vector_type(8)));
typedef short s16x4 __attribute__((ext_vector_type(4)));
typedef float f32x4 __attribute__((ext_vector_type(4)));
typedef float f32x2 __attribute__((ext_vector_type(2)));
typedef __bf16 bf16x2_t __attribute__((ext_vector_type(2)));
typedef unsigned u32x4 __attribute__((ext_vector_type(4)));
typedef unsigned u32x2 __attribute__((ext_vector_type(2)));
typedef long l64x2 __attribute__((ext_vector_type(2)));
typedef int i32x4 __attribute__((ext_vector_type(4)));
typedef int i32x8 __attribute__((ext_vector_type(8)));
typedef LAS char lchar;

constexpr int DM = 1024, BATCH = 8, SEQ = 2048, CTXL = 256, DEPTH = 2;
constexpr int T_LAT = BATCH * SEQ, T_CTX = BATCH * CTXL, T_ALL = T_LAT + T_CTX;
constexpr int IN_W = 2336, NP = 2560, NKV = 512;
constexpr int NEXP = 64, EDIM = 256;
constexpr float EPS = 1e-6f;
constexpr float LOG2E = 1.4426950408889634f;
constexpr float ACT_SCALE = 16.f, WD_SCALE = 64.f, H2_SCALE = 16.f, WGU_SCALE = 128.f;
constexpr int PC_AQ = 0, PC_AK = 256, PC_AV = 384, PC_BQN = 512, PC_BQR = 768, PC_CKV = 896, PC_CQ = 1024, PC_CK = 1280, PC_CV = 1408,
              PC_DQ = 1536, PC_DK = 1792, PC_DV = 2048, PC_BKR = 2304;
constexpr int RSLOTS = 147456 + 64 * 256;
constexpr int SH_BASE = RSLOTS;
constexpr int ACT_ROWS = RSLOTS + T_ALL;
constexpr int NT = 512, NW = NT / 64;
constexpr int RT_TILE = 16;
constexpr int MAX_RT = T_ALL / RT_TILE;

constexpr size_t al256(size_t x) { return (x + 255) & ~(size_t)255; }
constexpr size_t OFF_CTL = 0, CTL_BYTES = 65536;
constexpr size_t OFF_MOD = OFF_CTL + CTL_BYTES;
constexpr size_t OFF_TABH = al256(OFF_MOD + (size_t)2 * 9 * 6144 * 4);
constexpr size_t OFF_TABR = al256(OFF_TABH + (size_t)2048 * 32 * 8);
constexpr size_t OFF_WIN = al256(OFF_TABR + (size_t)2048 * 16 * 8);
constexpr size_t OFF_WOUT = al256(OFF_WIN + (size_t)2 * NP * 1024 * 2);
constexpr size_t OFF_WKV = al256(OFF_WOUT + (size_t)2 * 1024 * 1024 * 2);
constexpr size_t OFF_XC = al256(OFF_WKV + (size_t)2 * 512 * 128 * 2);
constexpr size_t OFF_E8 = al256(OFF_XC + (size_t)T_CTX * 1024 * 4);
constexpr size_t OFF_W8 = al256(OFF_E8 + (size_t)T_ALL * 8);
constexpr size_t OFF_LR8 = al256(OFF_W8 + (size_t)T_ALL * 8 * 4);
constexpr size_t OFF_TSL = al256(OFF_LR8 + (size_t)T_ALL * 8 * 2);
constexpr size_t OFF_STK = al256(OFF_TSL + (size_t)T_ALL * 8 * 4);
constexpr size_t OFF_HIST = al256(OFF_STK + (size_t)RSLOTS * 4);
constexpr size_t OFF_TOFF = al256(OFF_HIST + (size_t)MAX_RT * 64 * 4);
constexpr size_t OFF_CNT = al256(OFF_TOFF + (size_t)MAX_RT * 64 * 4);
constexpr size_t OFF_WRT = al256(OFF_CNT + 256);
constexpr size_t OFF_GOFF = al256(OFF_WRT + (size_t)2 * 64 * 1024 * 4);
constexpr size_t OFF_WD = al256(OFF_GOFF + (size_t)256 * 8 * 512 * 16);
constexpr size_t OFF_H = al256(OFF_WD + (size_t)65 * 1024 * 256 * 2);
constexpr size_t OFF_ACT = al256(OFF_H + (size_t)T_ALL * 1024 * 2);
constexpr size_t OFF_WGU = al256(OFF_ACT + (size_t)ACT_ROWS * 256 * 2);
constexpr size_t OFF_Y = OFF_WGU;
constexpr size_t OFF_P = al256(OFF_WGU + (size_t)65 * 512 * 1024 * 2);
constexpr size_t OFF_KVB = al256(OFF_P + (size_t)T_ALL * NP * 2);
constexpr size_t OFF_MIXIN = al256(OFF_KVB + (size_t)T_ALL * NKV * 2);
constexpr size_t OFF_MIX = al256(OFF_MIXIN + (size_t)T_ALL * 1024 * 2);
constexpr size_t OFF_MIXC = OFF_P;
constexpr size_t ATT_END = al256(OFF_MIX + (size_t)T_ALL * 1024 * 2);
constexpr size_t Y_END = al256(OFF_Y + (size_t)RSLOTS * 1024 * (Y8_ALL ? 1 : 2));
constexpr size_t OFF_XB = (ATT_END > Y_END ? ATT_END : Y_END);
constexpr size_t WS_NEED = al256(OFF_XB + (size_t)T_ALL * 1024 * 2);

constexpr int LDS_BYTES = 159888;
constexpr int GOFF_LDS = 139264;
constexpr int RSV_OFF = 131584, SEG_OFF = 132608;
constexpr int LDS_XB = LDS_BYTES - 16;

struct Params {
    const float *x, *c, *ctx, *c_ctx, *ada_w, *ada_b, *pre_mix_g, *post_mix_g, *pre_ffn_g, *post_ffn_g, *w_in, *a_q_norm, *a_k_norm,
        *b_kv_norm, *b_w_kv_up, *c_sink, *d_rpb, *w_out, *router_w, *router_b, *exp_w_gate, *exp_w_up, *exp_w_down, *sh_w_gate, *sh_w_up, *sh_w_down;
    float* out; char* ws; int ph_lo, ph_hi;
};

DEVI unsigned pk2(float lo, float hi) { f32x2 v = {lo, hi}; bf16x2_t b = __builtin_convertvector(v, bf16x2_t); return __builtin_bit_cast(unsigned, b); }
DEVI float bflo(unsigned u) { return __uint_as_float(u << 16); }
DEVI float bfhi(unsigned u) { return __uint_as_float(u & 0xffff0000u); }
template <int CTRL> DEVI float dpp_f(float v) { return __int_as_float(__builtin_amdgcn_update_dpp(0, __float_as_int(v), CTRL, 0xf, 0xf, false)); }
DEVI float gmax8(float v) { v = fmaxf(v, dpp_f<0xB1>(v)); v = fmaxf(v, dpp_f<0x4E>(v)); v = fmaxf(v, dpp_f<0x141>(v)); return v; }
DEVI float wave_max_dpp(float v) {
    v = fmaxf(v, dpp_f<0xB1>(v)); v = fmaxf(v, dpp_f<0x4E>(v)); v = fmaxf(v, dpp_f<0x141>(v)); v = fmaxf(v, dpp_f<0x140>(v));
    const int iv = __float_as_int(v);
    const float a = __int_as_float(__builtin_amdgcn_readlane(iv, 0)), b = __int_as_float(__builtin_amdgcn_readlane(iv, 16));
    const float c = __int_as_float(__builtin_amdgcn_readlane(iv, 32)), d = __int_as_float(__builtin_amdgcn_readlane(iv, 48));
    return fmaxf(fmaxf(a, b), fmaxf(c, d));
}
DEVI float wave_sum_dpp(float v) {
    v += dpp_f<0xB1>(v); v += dpp_f<0x4E>(v); v += dpp_f<0x141>(v); v += dpp_f<0x140>(v);
    const int iv = __float_as_int(v);
    const float a = __int_as_float(__builtin_amdgcn_readlane(iv, 0)), b = __int_as_float(__builtin_amdgcn_readlane(iv, 16));
    const float c = __int_as_float(__builtin_amdgcn_readlane(iv, 32)), d = __int_as_float(__builtin_amdgcn_readlane(iv, 48));
    return (a + b) + (c + d);
}
DEVI float wave_sum(float v) { return wave_sum_dpp(v); }

DEVI int ltid() { int t = threadIdx.x; asm volatile("" : "+v"(t)); return t; }
DEVI int vtid() { return ltid() & 255; }
DEVI float rows_max(float v) {
    { const auto r = __builtin_amdgcn_permlane16_swap(__float_as_uint(v), __float_as_uint(v), false, false); v = fmaxf(__uint_as_float(r[0]), __uint_as_float(r[1])); }
    { const auto r = __builtin_amdgcn_permlane32_swap(__float_as_uint(v), __float_as_uint(v), false, false); v = fmaxf(__uint_as_float(r[0]), __uint_as_float(r[1])); }
    return v;
}
DEVI float rows_sum(float v) {
    { const auto r = __builtin_amdgcn_permlane16_swap(__float_as_uint(v), __float_as_uint(v), false, false); v = __uint_as_float(r[0]) + __uint_as_float(r[1]); }
    { const auto r = __builtin_amdgcn_permlane32_swap(__float_as_uint(v), __float_as_uint(v), false, false); v = __uint_as_float(r[0]) + __uint_as_float(r[1]); }
    return v;
}
DEVI float fexp2(float x) { return __builtin_amdgcn_exp2f(x); }
DEVI float silu_f(float x) { return x * __builtin_amdgcn_rcpf(1.f + __builtin_amdgcn_exp2f(-LOG2E * x)); }

#define XB_TMO      128
#define XB_XCNT(j)  (256  + 64 * (j))
#define XB_XSUB(j)  (1280 + 64 * (j))
#define XB_XGEN(j)  (2304 + 64 * (j))
#define XB_TOP      3328
#define XB_TOPGEN   3392
#define XCD_BAR_WORDS 3456
#define XB_SPIN_CAP (1u << 18)

DEVI unsigned xb_ld(unsigned* p)              { return __hip_atomic_load(p, __ATOMIC_RELAXED, __HIP_MEMORY_SCOPE_AGENT); }
DEVI unsigned xb_add(unsigned* p, unsigned v) { return __hip_atomic_fetch_add(p, v, __ATOMIC_RELAXED, __HIP_MEMORY_SCOPE_AGENT); }
DEVI unsigned xb_xcc_id() { return (unsigned)__builtin_amdgcn_s_getreg((3 << 11) | 20) & 0xFu; }
#define XB_SPIN(cond, bar) do { unsigned _sp = 0; while (cond) { __builtin_amdgcn_s_sleep(1); \
    if ((++_sp & 255u) == 0u) { if (xb_ld(&(bar)[XB_TMO])) break; if (_sp > XB_SPIN_CAP) { atomicAdd(&(bar)[XB_TMO], 1u); break; } } } } while (0)

struct XcdBarrier { unsigned* bar; unsigned x; volatile LAS unsigned* st; };

DEVI XcdBarrier xcd_barrier_post(unsigned* bar, volatile LAS unsigned* st) {
    XcdBarrier b; b.bar = bar; b.x = xb_xcc_id(); b.st = st;
    if (threadIdx.x == 0) (void)xb_add(&bar[XB_XCNT(b.x)], 1u);
    return b;
}
DEVI void xcd_barrier_complete(unsigned* bar, unsigned x, unsigned& nloc, unsigned& nx) {
    const unsigned G = gridDim.x * gridDim.y * gridDim.z;
    unsigned sum, cnt, mine, sp = 0u;
    for (;;) {
        sum = 0u; cnt = 0u; mine = 0u;
#pragma unroll
        for (unsigned j = 0; j < 16; ++j) { const unsigned c = xb_ld(&bar[XB_XCNT(j)]); sum += c; cnt += (c > 0u) ? 1u : 0u; mine = (j == x) ? c : mine; }
        if (sum == G) break;
        __builtin_amdgcn_s_sleep(1);
        if ((++sp & 255u) == 0u) { if (xb_ld(&bar[XB_TMO])) break; if (sp > XB_SPIN_CAP) { atomicAdd(&bar[XB_TMO], 1u); break; } }
    }
    nloc = mine > 0u ? mine : 1u; nx = cnt > 0u ? cnt : 1u;
}
DEVI void xcd_barrier(const XcdBarrier& b) {
    asm volatile("s_waitcnt vmcnt(0)" ::: "memory");
    __syncthreads();
    if (threadIdx.x == 0) {
        unsigned* bar = b.bar;
        __builtin_amdgcn_s_waitcnt(0);
        unsigned nloc = b.st[0], nx = b.st[1];
        if (nloc == 0u) { xcd_barrier_complete(bar, b.x, nloc, nx); b.st[0] = nloc; b.st[1] = nx; }
        const unsigned old = xb_add(&bar[XB_XSUB(b.x)], 1u);
        const unsigned gen = old / nloc;
        if (old + 1u == (gen + 1u) * nloc) {
            __builtin_amdgcn_fence(__ATOMIC_RELEASE, "agent");
            asm volatile("s_waitcnt vmcnt(0)" ::: "memory");
            const unsigned og = xb_add(&bar[XB_TOP], 1u);
            const unsigned tg = og / nx;
            if (og + 1u == (tg + 1u) * nx) xb_add(&bar[XB_TOPGEN], 1u);
            else XB_SPIN(xb_ld(&bar[XB_TOPGEN]) == tg, bar);
            __builtin_amdgcn_fence(__ATOMIC_ACQUIRE, "agent");
            xb_add(&bar[XB_XGEN(b.x)], 1u);
            asm volatile("s_waitcnt vmcnt(0)" ::: "memory");
        } else {
            XB_SPIN(xb_ld(&bar[XB_XGEN(b.x)]) == gen, bar);
            __builtin_amdgcn_fence(__ATOMIC_ACQUIRE, "agent");
            asm volatile("s_waitcnt vmcnt(0)" ::: "memory");
        }
    }
    __syncthreads();
}

DEVI int lds_byte(int r, int c) { const int st = (r >> 4) * 2 + (c >> 5), rr = r & 15, cc = c & 31, ob = rr * 64 + cc * 2; return st * 1024 + (ob ^ (((ob >> 9) & 1) << 5)); }
DEVI void stage_rc(int b, int& R, int& C) { const int st = b / 1024, sb = b % 1024, swz = sb ^ (((sb >> 9) & 1) << 5); R = (st >> 1) * 16 + swz / 64; C = (st & 1) * 32 + (swz % 64) / 2; }

DEVI void glds16(const void* g, lchar* l) {
    __builtin_amdgcn_global_load_lds((const __attribute__((address_space(1))) unsigned*)g, (LAS unsigned*)l, 16, 0, 0);
}
constexpr int STG = 32768;
DEVI int stg128(int r, int cb) { return STG + r * 256 + (cb ^ ((r & 15) << 4)); }
DEVI int stg64(int r, int cb) { return STG + r * 128 + (cb ^ ((r & 7) << 4)); }

DEVI void acc_to_lds128(lchar* lds, const f32x4 (&acc)[4][4]) {
    const int tid = vtid(), wid = tid >> 6, lane = tid & 63, wr = wid >> 1, wc = wid & 1, fr = lane & 15, fq = lane >> 4;
#pragma unroll
    for (int m = 0; m < 4; ++m)
#pragma unroll
        for (int n = 0; n < 4; ++n) {
            u32x2 v = {pk2(acc[m][n][0], acc[m][n][1]), pk2(acc[m][n][2], acc[m][n][3])};
            *(LAS u32x2*)(lds + stg128(wr * 64 + m * 16 + fr, (wc * 64 + n * 16 + fq * 4) * 2)) = v;
        }
}
template <int NCOLS>
DEVI void tile_store(lchar* lds, bf16_t* out, size_t ld) {
    constexpr int CPR = NCOLS / 8;
    __syncthreads();
    for (int c = vtid(); c < 128 * CPR; c += 256) {
        const int r = c / CPR, pc = c % CPR;
        const u32x4 v = *(const LAS u32x4*)(lds + (NCOLS == 128 ? stg128(r, pc * 16) : stg64(r, pc * 16)));
        *(u32x4*)(out + (size_t)r * ld + pc * 8) = v;
    }
}

template <class Spec>
DEVI void gemm_phase(lchar* lds0, const Spec& S) {
    constexpr int NKT = Spec::NKT;
    static_assert(NKT % 2 == 0, "NKT must be even");
    const int t512 = ltid(), vb = t512 >> 8, tid = t512 & 255;
    lchar* lds = lds0 + vb * 65536;
    const int VG = gridDim.x * 2, vbid = blockIdx.x * 2 + vb, nu = S.count();
    const int trips = (nu + VG - 1) / VG;
    if (trips == 0) return;
    const int wid = tid >> 6, lane = tid & 63, wr = wid >> 1, wc = wid & 1, fr = lane & 15, fq = lane >> 4;
    int sR[4], sC[4];
#pragma unroll
    for (int i = 0; i < 4; ++i) stage_rc(tid * 16 + i * 4096, sR[i], sC[i]);
    int u = min(vbid, nu - 1);
    const bf16_t* ap[4]; const bf16_t* bp[4];
#pragma unroll
    for (int i = 0; i < 4; ++i) { ap[i] = S.a_row(u, sR[i]) + sC[i]; bp[i] = S.b_row(u, sR[i]) + sC[i]; }
    lchar* sA = lds + wid * 1024; lchar* sB = lds + 16384 + wid * 1024;
    const int aoff = lds_byte(wr * 64 + fr, fq * 8), boff = 16384 + lds_byte(wc * 64 + fr, fq * 8);
#pragma unroll
    for (int i = 0; i < 4; ++i) { glds16(ap[i], sA + i * 4096); glds16(bp[i], sB + i * 4096); }
    for (int trip = 0; trip < trips; ++trip) {
        const bool has_next = trip + 1 < trips;
        const int un = min(vbid + (trip + 1) * VG, nu - 1);
        f32x4 acc[4][4];
#pragma unroll
        for (int m = 0; m < 4; ++m)
#pragma unroll
            for (int n = 0; n < 4; ++n) acc[m][n] = (f32x4){0.f, 0.f, 0.f, 0.f};
        for (int t = 0; t < NKT; ++t) {
            const int cur = t & 1;
            asm volatile("s_waitcnt vmcnt(0)" ::: "memory");
            __syncthreads();
            if (t + 1 < NKT) {
                const int nb = (cur ^ 1) * 32768, ko = (t + 1) * 64;
#pragma unroll
                for (int i = 0; i < 4; ++i) { glds16(ap[i] + ko, sA + nb + i * 4096); glds16(bp[i] + ko, sB + nb + i * 4096); }
            } else if (has_next) {
#pragma unroll
                for (int i = 0; i < 4; ++i) { ap[i] = S.a_row(un, sR[i]) + sC[i]; bp[i] = S.b_row(un, sR[i]) + sC[i]; }
#pragma unroll
                for (int i = 0; i < 4; ++i) { glds16(ap[i], sA + i * 4096); glds16(bp[i], sB + i * 4096); }
            }
            const lchar* A = lds + cur * 32768 + aoff; const lchar* B = lds + cur * 32768 + boff;
#pragma unroll
            for (int ks = 0; ks < 2; ++ks) {
                bf16x8 a[4], b[4];
#pragma unroll
                for (int m = 0; m < 4; ++m) a[m] = *(const LAS bf16x8*)(A + m * 2048 + ks * 1024);
#pragma unroll
                for (int n = 0; n < 4; ++n) b[n] = *(const LAS bf16x8*)(B + n * 2048 + ks * 1024);
#pragma unroll
                for (int m = 0; m < 4; ++m)
#pragma unroll
                    for (int n = 0; n < 4; ++n) acc[m][n] = __builtin_amdgcn_mfma_f32_16x16x32_bf16(b[n], a[m], acc[m][n], 0, 0, 0);
            }
        }
        __syncthreads();
        S.epi(u, acc, lds);
        u = un;
    }
    __syncthreads();
}

struct SrcRow { const float* p; int stride; float mul; };

template <class RF>
DEVI void conv_tile(lchar* lds, const RF& rf, int n0, int k0, bf16_t* dst, int K, const float* kscale) {
    LAS float* t = (LAS float*)lds;
    const int tid = ltid(), nn = tid & 63, kq = tid >> 6;
    const SrcRow sr = rf(n0 + nn);
    const float* src = sr.p + (size_t)(k0 + kq) * sr.stride;
    const size_t step = (size_t)NW * sr.stride;
    float v[64 / NW];
#pragma unroll
    for (int i = 0; i < 64 / NW; ++i) v[i] = src[i * step];
    if (kscale) {
#pragma unroll
        for (int i = 0; i < 64 / NW; ++i) v[i] *= kscale[k0 + kq + i * NW];
    }
#pragma unroll
    for (int i = 0; i < 64 / NW; ++i) t[(kq + i * NW) * 65 + nn] = v[i] * sr.mul;
    __syncthreads();
    {
        const int r = tid >> 3, kc = tid & 7;
        unsigned w[4];
#pragma unroll
        for (int q = 0; q < 4; ++q) w[q] = pk2(t[(kc * 8 + 2 * q) * 65 + r], t[(kc * 8 + 2 * q + 1) * 65 + r]);
        *(uint4*)(dst + (size_t)(n0 + r) * K + k0 + kc * 8) = make_uint4(w[0], w[1], w[2], w[3]);
    }
    __syncthreads();
}

DEVI int rope32_orig(int i) { const int seg = i >> 3, w = i & 7; return (seg == 0 ? 0 : seg == 1 ? 16 : seg == 2 ? 8 : 24) + w; }
DEVI int win_src_col(int r) {
    if (r < 512) return r;
    if (r < 768) { const int h = (r - 512) >> 6, i = (r - 512) & 63; return 512 + h * 96 + i; }
    if (r < 896) { const int h = (r - 768) >> 5, i = (r - 768) & 31; return 512 + h * 96 + 64 + rope32_orig(i); }
    if (r < 1024) return r;
    if (r < 2304) return r + 32;
    if (r < 2336) return 1024 + rope32_orig(r - 2304);
    return -1;
}

DEVI int qperm(int pos) { return ((pos >> 2) & 1) * 16 + (pos >> 3) * 4 + (pos & 3); }
DEVI bool roped64(int g) { return g < 6 || (g >= 16 && g < 22) || g == 12 || g == 13 || g == 36; }
DEVI int win_src_col2(int r) { if (r >= 2336) return -1; return win_src_col(roped64(r >> 6) ? (r & ~31) + qperm(r & 31) : r); }
constexpr int CT_WIN = (NP / 64) * 16, CT_WOUT = 16 * 16, CT_WKV = 8 * 2, CT_SMALL = CT_WIN + CT_WOUT + CT_WKV;
constexpr int CT_GU = 65 * 128, CT_DN = 65 * 64, CT_EXP = CT_GU + CT_DN;

DEVI void conv_small_tile(lchar* lds, const Params& p, int l, int t) {
    char* ws = p.ws;
    if (t < CT_WIN) {
        const int n0 = (t / 16) * 64, k0 = (t % 16) * 64;
        const float* src = p.w_in + (size_t)l * 1024 * IN_W;
        auto rf = [&](int r) { const int c = win_src_col2(r); SrcRow s; s.p = src + (c >= 0 ? c : 0); s.stride = IN_W; s.mul = c >= 0 ? 1.f : 0.f; return s; };
        conv_tile(lds, rf, n0, k0, (bf16_t*)(ws + OFF_WIN) + (size_t)l * NP * 1024, 1024, nullptr);
    } else if (t < CT_WIN + CT_WOUT) {
        t -= CT_WIN;
        const int n0 = (t / 16) * 64, k0 = (t % 16) * 64;
        const float* src = p.w_out + (size_t)l * 1024 * 1024;
        auto rf = [&](int r) { SrcRow s; s.p = src + r; s.stride = 1024; s.mul = 1.f; return s; };
        conv_tile(lds, rf, n0, k0, (bf16_t*)(ws + OFF_WOUT) + (size_t)l * 1024 * 1024, 1024, nullptr);
    } else {
        t -= CT_WIN + CT_WOUT;
        const int n0 = (t / 2) * 64, k0 = (t % 2) * 64;
        const float* src = p.b_w_kv_up + (size_t)l * 128 * 512;
        auto rf = [&](int r) { SrcRow s; s.p = src + r; s.stride = 512; s.mul = 1.f; return s; };
        conv_tile(lds, rf, n0, k0, (bf16_t*)(ws + OFF_WKV) + (size_t)l * 512 * 128, 128, p.b_kv_norm + l * 128);
    }
}
DEVI void conv_exp_tile(lchar* lds, const Params& p, int l, int t) {
    char* ws = p.ws;
    if (t < CT_GU) {
        const int e = t / 128, tt = t % 128, n0 = (tt / 16) * 64, k0 = (tt % 16) * 64;
        const float* g = e < 64 ? p.exp_w_gate + ((size_t)l * 64 + e) * 1024 * 256 : p.sh_w_gate + (size_t)l * 1024 * 256;
        const float* u = e < 64 ? p.exp_w_up + ((size_t)l * 64 + e) * 1024 * 256 : p.sh_w_up + (size_t)l * 1024 * 256;
        auto rf = [&](int r) { const int nt = r >> 8, hf = (r >> 7) & 1, c = r & 127; SrcRow s; s.p = (hf ? u : g) + nt * 128 + c; s.stride = 256; s.mul = 1.f; return s; };
        conv_tile(lds, rf, n0, k0, (bf16_t*)(ws + OFF_WGU) + (size_t)e * 512 * 1024, 1024, nullptr);
    } else {
        t -= CT_GU;
        const int e = t / 64, tt = t % 64, n0 = (tt / 4) * 64, k0 = (tt % 4) * 64;
        const float* d = e < 64 ? p.exp_w_down + ((size_t)l * 64 + e) * 256 * 1024 : p.sh_w_down + (size_t)l * 256 * 1024;
        auto rf = [&](int r) { SrcRow s; s.p = d + r; s.stride = 1024; s.mul = 1.f; return s; };
        conv_tile(lds, rf, n0, k0, (bf16_t*)(ws + OFF_WD) + (size_t)e * 1024 * 256, 256, nullptr);
    }
}


constexpr int CW = (NP / 64) * 4, CO = 16 * 4, CSM = CW + CO;
constexpr int CG = 65 * 8 * 4, CDN = 65 * 16, CEX = CG + CDN;
struct CD { const float* src; int stride; float mul; bf16_t* dst; int n0, k0, K; };
DEVI CD cdesc(const Params& p, int job, int T) {
    const int tid = ltid(), nn = tid & 63, kq = tid >> 6;
    CD d; int t, l;
    bool small = false;
    if (job == 0) { small = true; l = T / CSM; t = T % CSM; } else { l = job == 1 ? 1 : 0; t = T; }
    if (small) {
        if (t < CW) { d.n0 = (t >> 2) * 64; d.k0 = (t & 3) * 256; const int c = win_src_col2(d.n0 + nn);
            d.src = p.w_in + (size_t)l * 1024 * IN_W + (c >= 0 ? c : 0); d.stride = IN_W; d.mul = c >= 0 ? 1.f : 0.f; d.dst = (bf16_t*)(p.ws + OFF_WIN) + (size_t)l * NP * 1024; d.K = 1024; }
        else { t -= CW; d.n0 = (t >> 2) * 64; d.k0 = (t & 3) * 256;
            d.src = p.w_out + (size_t)l * 1024 * 1024 + d.n0 + nn; d.stride = 1024; d.mul = 1.f; d.dst = (bf16_t*)(p.ws + OFF_WOUT) + (size_t)l * 1024 * 1024; d.K = 1024; }
    } else if (t < CG) {
        const int e = t >> 5, tt = t & 31; d.n0 = (tt >> 2) * 64; d.k0 = (tt & 3) * 256;
        const int r = d.n0 + nn, nt = r >> 8, hf = (r >> 7) & 1, c = r & 127;
        const float* g = e < 64 ? p.exp_w_gate + ((size_t)l * 64 + e) * 1024 * 256 : p.sh_w_gate + (size_t)l * 1024 * 256;
        const float* u = e < 64 ? p.exp_w_up + ((size_t)l * 64 + e) * 1024 * 256 : p.sh_w_up + (size_t)l * 1024 * 256;
        d.src = (hf ? u : g) + nt * 128 + c; d.stride = 256; d.mul = 1.f; d.dst = (bf16_t*)(p.ws + OFF_WGU) + (size_t)e * 512 * 1024; d.K = 1024;
    } else {
        t -= CG; const int e = t >> 4; d.n0 = (t & 15) * 64; d.k0 = 0;
        const float* dn = e < 64 ? p.exp_w_down + ((size_t)l * 64 + e) * 256 * 1024 : p.sh_w_down + (size_t)l * 256 * 1024;
        d.src = dn + d.n0 + nn; d.stride = 1024; d.mul = 1.f; d.dst = (bf16_t*)(p.ws + OFF_WD) + (size_t)e * 1024 * 256; d.K = 256;
    }
    d.src += (size_t)(d.k0 + kq) * d.stride;
    return d;
}
DEVI void cload(const CD& d, float (&v)[32]) {
    const size_t step = (size_t)8 * d.stride;
#pragma unroll
    for (int i = 0; i < 32; ++i) v[i] = d.src[i * step];
}
DEVI void cstore(lchar* lds, const CD& d, const float (&v)[32]) {
    LAS float* t = (LAS float*)lds;
    const int tid = ltid(), nn = tid & 63, kq = tid >> 6;
#pragma unroll
    for (int i = 0; i < 32; ++i) t[(kq + i * 8) * 65 + nn] = v[i] * d.mul;
    __syncthreads();
#pragma unroll
    for (int i = 0; i < 4; ++i) {
        const int idx = tid + i * 512, r = (idx >> 2) & 63, kc = (idx & 3) + ((idx >> 8) << 2);
        unsigned w[4];
#pragma unroll
        for (int q = 0; q < 4; ++q) w[q] = pk2(t[(kc * 8 + 2 * q) * 65 + r], t[(kc * 8 + 2 * q + 1) * 65 + r]);
        *(uint4*)(d.dst + (size_t)(d.n0 + r) * d.K + d.k0 + kc * 8) = make_uint4(w[0], w[1], w[2], w[3]);
    }
    __syncthreads();
}
DEVI void conv_stream(lchar* lds, const Params& p, int job, int Tend) {
    const int G = gridDim.x;
    int T = blockIdx.x;
    if (T >= Tend) return;
    CD d = cdesc(p, job, T);
    float a[32];
    cload(d, a);
#pragma unroll 1
    for (;;) {
        const int Tn = T + G; const bool has = Tn < Tend;
        CD dn = d; float b[32];
        if (has) { dn = cdesc(p, job, Tn); cload(dn, b); }
        cstore(lds, d, a);
        if (!has) break;
        d = dn; T = Tn;
#pragma unroll
        for (int i = 0; i < 32; ++i) a[i] = b[i];
    }
}

DEVI void ada_unit(lchar* lds, const Params& p, int u) {
    LAS float* ca = (LAS float*)lds;
    LAS float* red = (LAS float*)(lds + 9 * 1024 * 4);
    const int tid = ltid(), l = u / 96, cg = u % 96, col = cg * 64 + (tid & 63), kq = tid >> 6;
    for (int i = tid; i < 9 * 1024; i += NT) { const float v = i < 8192 ? p.c[i] : p.c_ctx[i - 8192]; ca[i] = silu_f(v); }
    __syncthreads();
    float acc[9];
#pragma unroll
    for (int b = 0; b < 9; ++b) acc[b] = 0.f;
    const float* w = p.ada_w + (size_t)l * 1024 * 6144 + col;
    for (int k0 = kq * (1024 / NW); k0 < (kq + 1) * (1024 / NW); k0 += 16) {
        float wv[16];
#pragma unroll
        for (int i = 0; i < 16; ++i) wv[i] = w[(size_t)(k0 + i) * 6144];
#pragma unroll
        for (int i = 0; i < 16; ++i)
#pragma unroll
            for (int b = 0; b < 9; ++b) acc[b] += ca[b * 1024 + k0 + i] * wv[i];
    }
#pragma unroll
    for (int b = 0; b < 9; ++b) red[(kq * 9 + b) * 64 + (tid & 63)] = acc[b];
    __syncthreads();
    float* mod = (float*)(p.ws + OFF_MOD);
    for (int i = tid; i < 9 * 64; i += NT) {
        const int b = i >> 6, c = i & 63;
        float s = 0.f;
#pragma unroll
        for (int w = 0; w < NW; ++w) s += red[(w * 9 + b) * 64 + c];
        mod[((size_t)l * 9 + b) * 6144 + cg * 64 + c] = s + p.ada_b[l * 6144 + cg * 64 + c];
    }
    __syncthreads();
}

DEVI void rope_tables(const Params& p, int gtid, int gn) {
    float2* th = (float2*)(p.ws + OFF_TABH); float2* tr = (float2*)(p.ws + OFF_TABR);
    for (int i = gtid; i < 2048 * 48; i += gn) {
        const int pos = i / 48, a = i % 48;
        const double row = (double)(pos / 64), col = (double)(pos % 64);
        double ang;
        if (a < 32) { const int q = a & 15; ang = ((a < 16) ? row : col) * pow(10000.0, -(double)q / 16.0); }
        else { const int aa = a - 32, q = aa & 7; ang = ((aa < 8) ? row : col) * pow(10000.0, -(double)q / 8.0); }
        const float2 v = make_float2((float)cos(ang), (float)sin(ang));
        if (a < 32) th[pos * 32 + a] = v; else tr[pos * 16 + (a - 32)] = v;
    }
}

DEVI void phase_s0(lchar* lds, const Params& p) {
    const int G = gridDim.x, bid = blockIdx.x;
    rope_tables(p, bid * NT + ltid(), G * NT);
    { u32x4* wrt = (u32x4*)(p.ws + OFF_WRT);
      for (int i = bid * NT + ltid(); i < 2 * 4 * 32 * 64; i += G * NT) { const int l = i >> 13, w = (i >> 11) & 3, sk = (i >> 6) & 31, ln = i & 63;
          const float* src = p.router_w + ((size_t)l * 1024 + sk * 32 + (ln >> 4) * 8) * 64 + w * 16 + (ln & 15);
          u32x4 hi, lo;
#pragma unroll
          for (int j = 0; j < 4; ++j) { const float a = src[(2 * j) * 64], b = src[(2 * j + 1) * 64]; const unsigned h = pk2(a, b); hi[j] = h; lo[j] = pk2(a - bflo(h), b - bfhi(h)); }
          u32x4* dst = wrt + ((size_t)((l * 4 + w) * 32 + sk) * 2) * 64 + ln;
          dst[0] = hi; dst[64] = lo; } }
    for (int u = bid; u < 192; u += G) ada_unit(lds, p, u);
    for (int t = bid; t < 2 * CT_WKV; t += G) conv_small_tile(lds, p, t / CT_WKV, CT_WIN + CT_WOUT + t % CT_WKV);
    conv_stream(lds, p, 0, 2 * CSM);
}

DEVI const float* xrow_ptr(const Params& p, int l, int r) {
    if (r < T_LAT) return (l == 0 ? p.x : p.out) + (size_t)r * 1024;
    return (l == 0 ? p.ctx : (const float*)(p.ws + OFF_XC)) + (size_t)(r - T_LAT) * 1024;
}
DEVI void phase_s1(const Params& p, int l) {
    const int wid = ltid() >> 6, lane = ltid() & 63;
    const int gw = blockIdx.x * NW + wid, nw = gridDim.x * NW;
    const float* g = p.pre_mix_g + l * 1024;
    bf16_t* H = (bf16_t*)(p.ws + OFF_H);
    for (int r = gw; r < T_ALL; r += nw) {
        const float* xr = xrow_ptr(p, l, r);
        const int bb = r < T_LAT ? (r >> 11) : 8;
        const float* mod = (const float*)(p.ws + OFF_MOD) + ((size_t)l * 9 + bb) * 6144;
        float4 v[4]; float ss = 0.f;
#pragma unroll
        for (int i = 0; i < 4; ++i) { v[i] = *(const float4*)(xr + i * 256 + lane * 4); ss += v[i].x * v[i].x + v[i].y * v[i].y + v[i].z * v[i].z + v[i].w * v[i].w; }
        ss = wave_sum(ss);
        const float rs = rsqrtf(ss * (1.f / 1024.f) + EPS);
#pragma unroll
        for (int i = 0; i < 4; ++i) {
            const int c = i * 256 + lane * 4;
            const float4 gg = *(const float4*)(g + c), sh = *(const float4*)(mod + c), sc = *(const float4*)(mod + 1024 + c);
            const float a0 = v[i].x * rs * gg.x * (1.f + sc.x) + sh.x, a1 = v[i].y * rs * gg.y * (1.f + sc.y) + sh.y;
            const float a2 = v[i].z * rs * gg.z * (1.f + sc.z) + sh.z, a3 = v[i].w * rs * gg.w * (1.f + sc.w) + sh.w;
            *(uint2*)(H + (size_t)r * 1024 + c) = make_uint2(pk2(a0, a1), pk2(a2, a3));
        }
    }
}

struct InprojSpec {
    static constexpr int NKT = 16;
    const Params& p; int l;
    DEVI int count() const { return (T_ALL / 128) * 19; }
    DEVI const bf16_t* a_row(int u, int R) const { return (const bf16_t*)(p.ws + OFF_H) + ((size_t)(u / 19) * 128 + R) * 1024; }
    DEVI const bf16_t* b_row(int u, int R) const { return (const bf16_t*)(p.ws + OFF_WIN) + ((size_t)l * NP + (u % 19) * 128 + R) * 1024; }
    DEVI void epi(int u, f32x4 (&acc)[4][4], lchar* lds) const {
        const int mt = u / 19, nt = u % 19;
        const int tid = vtid(), wid = tid >> 6, lane = tid & 63, wr = wid >> 1, wc = wid & 1, fr = lane & 15, fq = lane >> 4;
        const int g = nt * 2 + wc;
        const bool lat = mt < (T_LAT / 128);
        const bool do_norm = g < 6;
        const int rope = ((g < 6) || (g >= 16 && g < 22)) ? 1 : ((g == 12 || g == 13 || g == 36) ? 2 : 0);
        const float SA = 0.125f * LOG2E, SB = 0.10206207261596577f * LOG2E;
        const float scale = ((g < 4) || (g >= 16 && g < 20) || (g >= 24 && g < 28)) ? SA : ((g >= 8 && g < 14) ? SB : 1.f);
        if (do_norm) {
            const float* gn = (g < 4 ? p.a_q_norm : p.a_k_norm) + l * 64;
            float gv[4][4];
#pragma unroll
            for (int n = 0; n < 4; ++n)
#pragma unroll
                for (int j = 0; j < 4; ++j) gv[n][j] = gn[n * 16 + fq * 4 + j];
#pragma unroll
            for (int m = 0; m < 4; ++m) {
                float ss = 0.f;
#pragma unroll
                for (int n = 0; n < 4; ++n)
#pragma unroll
                    for (int j = 0; j < 4; ++j) ss += acc[m][n][j] * acc[m][n][j];
                ss = rows_sum(ss);
                const float rs = rsqrtf(ss * (1.f / 64.f) + EPS);
#pragma unroll
                for (int n = 0; n < 4; ++n)
#pragma unroll
                    for (int j = 0; j < 4; ++j) acc[m][n][j] *= rs * gv[n][j];
            }
        }
        if (rope != 0 && lat) {
            const float* tab = (const float*)(p.ws + (rope == 1 ? OFF_TABH : OFF_TABR));
            const int tw = rope == 1 ? 32 : 16;
#pragma unroll
            for (int m = 0; m < 4; ++m) {
                const int pos = (mt * 128 + wr * 64 + m * 16 + fr) & 2047;
#pragma unroll
                for (int hf = 0; hf < 2; ++hf) {
                    const int a0 = (rope == 1 ? hf * 16 : 0) + fq * 4;
                    const float4 t0 = *(const float4*)(tab + ((size_t)pos * tw + a0) * 2), t1 = *(const float4*)(tab + ((size_t)pos * tw + a0) * 2 + 4);
                    const float cs[4] = {t0.x, t0.z, t1.x, t1.z}, sn[4] = {t0.y, t0.w, t1.y, t1.w};
#pragma unroll
                    for (int j = 0; j < 4; ++j) {
                        const float x1 = acc[m][2 * hf][j], x2 = acc[m][2 * hf + 1][j];
                        acc[m][2 * hf][j] = x1 * cs[j] - x2 * sn[j];
                        acc[m][2 * hf + 1][j] = x2 * cs[j] + x1 * sn[j];
                    }
                }
            }
        }
        if (scale != 1.f) {
#pragma unroll
            for (int m = 0; m < 4; ++m)
#pragma unroll
                for (int n = 0; n < 4; ++n) acc[m][n] *= scale;
        }
        acc_to_lds128(lds, acc);
        tile_store<128>(lds, (bf16_t*)(p.ws + OFF_P) + (size_t)mt * 128 * NP + nt * 128, NP);
    }
};

struct KvupSpec {
    static constexpr int NKT = 2;
    const Params& p; int l; lchar* lds0;
    DEVI int count() const { return (T_ALL / 128) * 4; }
    DEVI const bf16_t* a_row(int u, int R) const { return (const bf16_t*)(p.ws + OFF_P) + ((size_t)(u >> 2) * 128 + R) * NP + PC_CKV; }
    DEVI const bf16_t* b_row(int u, int R) const { return (const bf16_t*)(p.ws + OFF_WKV) + ((size_t)l * 512 + (u & 3) * 128 + R) * 128; }
    DEVI void epi(int u, f32x4 (&acc)[4][4], lchar* lds) const {
        const int mt = u >> 2, nt = u & 3;
        const int tid = vtid(), wid = tid >> 6, lane = tid & 63, wr = wid >> 1, fr = lane & 15;
        LAS float* rsv = (LAS float*)(lds0 + RSV_OFF + (ltid() >> 8) * 512);
        {
            const int r = tid >> 1, hf = tid & 1;
            const u32x4* src = (const u32x4*)(a_row(u, r) + hf * 64);
            float ss = 0.f;
#pragma unroll
            for (int i = 0; i < 8; ++i) { const u32x4 v = src[i];
#pragma unroll
                for (int q = 0; q < 4; ++q) { const float a = bflo(v[q]), b = bfhi(v[q]); ss += a * a + b * b; } }
            ss += dpp_f<0xB1>(ss);
            if (hf == 0) rsv[r] = rsqrtf(ss * (1.f / 128.f) + EPS);
        }
        __syncthreads();
#pragma unroll
        for (int m = 0; m < 4; ++m) { const float rs = rsv[wr * 64 + m * 16 + fr];
#pragma unroll
            for (int n = 0; n < 4; ++n) acc[m][n] *= rs; }
        acc_to_lds128(lds, acc);
        tile_store<128>(lds, (bf16_t*)(p.ws + OFF_KVB) + (size_t)mt * 128 * NKV + nt * 128, NKV);
    }
};

struct OutprojSpec {
    static constexpr int NKT = 16;
    const Params& p; int l; int nmt;
    DEVI int count() const { return nmt * 8; }
    DEVI const bf16_t* a_row(int u, int R) const { return (const bf16_t*)(p.ws + OFF_MIXIN) + ((size_t)(u >> 3) * 128 + R) * 1024; }
    DEVI const bf16_t* b_row(int u, int R) const { return (const bf16_t*)(p.ws + OFF_WOUT) + ((size_t)l * 1024 + (u & 7) * 128 + R) * 1024; }
    DEVI void epi(int u, f32x4 (&acc)[4][4], lchar* lds) const {
        acc_to_lds128(lds, acc);
        tile_store<128>(lds, (bf16_t*)(p.ws + OFF_MIX) + (size_t)(u >> 3) * 128 * 1024 + (u & 7) * 128, 1024);
    }
};

DEVI void build_seg(lchar* lds, const Params& p) {
    LAS int* seg = (LAS int*)(lds + SEG_OFF);
    const int* cnt = (const int*)(p.ws + OFF_CNT);
    if (ltid() < 64) {
        const int lane = ltid(), pc = (cnt[lane] + 255) & ~255;
        int inc = 0;
#pragma unroll
        for (int j = 0; j < 64; ++j) { const int sj = __builtin_amdgcn_readlane(pc, j); if (lane >= j) inc += sj; }
        seg[lane] = inc - pc;
        if (lane == 63) seg[64] = inc;
    }
    __syncthreads();
}
DEVI int seg_expert(lchar* lds, int slot) {
    LAS int* seg = (LAS int*)(lds + SEG_OFF);
    int e = 0;
#pragma unroll
    for (int s = 32; s; s >>= 1) if (seg[e + s] <= slot) e += s;
    return e;
}

struct GateupSpec {
    static constexpr int NKT = 16;
    const Params& p; lchar* lds; int nmt_r, nmt_all;
    DEVI int count() const { return (nmt_r + nmt_all) * 4; }
    DEVI const bf16_t* a_row(int u, int R) const {
        const int mt = u >> 2; const bf16_t* H = (const bf16_t*)(p.ws + OFF_H);
        if (mt >= nmt_r) return H + ((size_t)(mt - nmt_r) * 128 + R) * 1024;
        return H + (size_t)((const int*)(p.ws + OFF_STK))[mt * 128 + R] * 1024;
    }
    DEVI const bf16_t* b_row(int u, int R) const {
        const int mt = u >> 2, e = mt >= nmt_r ? 64 : seg_expert(lds, mt * 128);
        return (const bf16_t*)(p.ws + OFF_WGU) + ((size_t)e * 512 + (u & 3) * 128 + R) * 1024;
    }
    DEVI void epi(int u, f32x4 (&acc)[4][4], lchar* l_) const {
        const int mt = u >> 2, nt = u & 3, row0 = mt >= nmt_r ? SH_BASE + (mt - nmt_r) * 128 : mt * 128;
        const int tid = vtid(), wid = tid >> 6, lane = tid & 63, wr = wid >> 1, wc = wid & 1, fr = lane & 15, fq = lane >> 4;
#pragma unroll
        for (int m = 0; m < 4; ++m)
#pragma unroll
            for (int hf = 0; hf < 2; ++hf) {
                float a[4];
#pragma unroll
                for (int j = 0; j < 4; ++j) a[j] = silu_f(acc[m][2 * hf][j]) * acc[m][2 * hf + 1][j];
                u32x2 v = {pk2(a[0], a[1]), pk2(a[2], a[3])};
                *(LAS u32x2*)(l_ + stg64(wr * 64 + m * 16 + fr, (wc * 32 + hf * 16 + fq * 4) * 2)) = v;
            }
        tile_store<64>(l_, (bf16_t*)(p.ws + OFF_ACT) + (size_t)row0 * 256 + nt * 64, 256);
    }
};

struct DownSpec {
    static constexpr int NKT = 4;
    const Params& p; lchar* lds; int nmt_r, nmt_all;
    DEVI int count() const { return (nmt_r + nmt_all) * 8; }
    DEVI int row0(int mt) const { return mt >= nmt_r ? SH_BASE + (mt - nmt_r) * 128 : mt * 128; }
    DEVI const bf16_t* a_row(int u, int R) const { return (const bf16_t*)(p.ws + OFF_ACT) + ((size_t)row0(u >> 3) + R) * 256; }
    DEVI const bf16_t* b_row(int u, int R) const {
        const int mt = u >> 3, e = mt >= nmt_r ? 64 : seg_expert(lds, mt * 128);
        return (const bf16_t*)(p.ws + OFF_WD) + ((size_t)e * 1024 + (u & 7) * 128 + R) * 256;
    }
    DEVI void epi(int u, f32x4 (&acc)[4][4], lchar* l_) const {
        const int mt = u >> 3, nt = u & 7;
        acc_to_lds128(l_, acc);
        bf16_t* out = mt >= nmt_r ? (bf16_t*)(p.ws + OFF_H) + (size_t)(mt - nmt_r) * 128 * 1024 : (bf16_t*)(p.ws + OFF_Y) + (size_t)mt * 128 * 1024;
        tile_store<128>(l_, out + nt * 128, 1024);
    }
};

DEVI int perm32(int rho) { const int n = rho >> 4, i = rho & 15; return 8 * (i >> 2) + 4 * n + (i & 3); }
template <class Spec>
DEVI void gemm8_phase(lchar* lds, const Spec& S) {
    constexpr int K = Spec::K, NKT = K / 64, HTB = 16384;
    static_assert(NKT % 2 == 0 && NKT >= 2, "K must be a multiple of 128");
    int u = S.unit(0);
    if (u < 0) return;
    const int tid = ltid(), wid = __builtin_amdgcn_readfirstlane(tid >> 6), lane = tid & 63, wr = wid >> 2, wc = wid & 3, fr = lane & 15, fq = lane >> 4;
    int sR[2], sC[2]; unsigned voffB[2];
#pragma unroll
    for (int i = 0; i < 2; ++i) { stage_rc(tid * 16 + i * 8192, sR[i], sC[i]); const int Rb = (Spec::REMAP ? (sR[i] >> 5) * 64 : (sR[i] & ~31)) + perm32(sR[i] & 31); voffB[i] = (unsigned)(Rb * Spec::BPITCH + sC[i]) * 2u; }
    constexpr size_t kstep = 128, hstepB = (size_t)(Spec::REMAP ? 32 : 128) * Spec::BPITCH * 2;
    const unsigned ldsw = (unsigned)wid * 1024u;
    const int aoff = lds_byte(wr * 64 + fr, fq * 8), boff = lds_byte(wc * 32 + fr, fq * 8);
#define G8_SA(b, h) (((b) * 2 + (h)) * HTB)
#define G8_SB(b, h) ((4 + (b) * 2 + (h)) * HTB)
#define G8_STAGE(bufoff, gbase, voff) do { _Pragma("unroll") for (int _i = 0; _i < 2; ++_i) { unsigned vo_ = (voff)[_i]; if constexpr (NKT == 2) asm volatile("" : "+v"(vo_));     \
        __builtin_amdgcn_global_load_lds((const __attribute__((address_space(1))) unsigned*)((const char*)(gbase) + vo_), (LAS unsigned*)(lds + (bufoff) + ldsw + _i * 8192), 16, 0, 0); } } while (0)
#define G8_LDA(dst, b, h) do { _Pragma("unroll") for (int m = 0; m < 4; ++m) dst[m] = __builtin_shufflevector(*(const LAS i32x4*)(lds + G8_SA(b, h) + aoff + m * 2048), *(const LAS i32x4*)(lds + G8_SA(b, h) + aoff + m * 2048 + 1024), 0, 1, 2, 3, 4, 5, 6, 7); } while (0)
#define G8_LDB(dst, b, h) do { _Pragma("unroll") for (int n = 0; n < 2; ++n) dst[n] = __builtin_shufflevector(*(const LAS i32x4*)(lds + G8_SB(b, h) + boff + n * 2048), *(const LAS i32x4*)(lds + G8_SB(b, h) + boff + n * 2048 + 1024), 0, 1, 2, 3, 4, 5, 6, 7); } while (0)
#define G8_HALF(v, k) __builtin_bit_cast(bf16x8, (k) == 0 ? __builtin_shufflevector(v, v, 0, 1, 2, 3) : __builtin_shufflevector(v, v, 4, 5, 6, 7))
#ifndef FP8_MX
#define FP8_MX 1
#endif
#define G8_MMA(ai, bj, At, Bt) do { __builtin_amdgcn_s_setprio(1); _Pragma("unroll") for (int m = 0; m < 4; ++m) _Pragma("unroll") for (int n = 0; n < 2; ++n) { \
        if constexpr (Spec::FP8 && Spec::MX && FP8_MX) { \
            acc[ai][bj][m][n] = __builtin_amdgcn_mfma_scale_f32_16x16x128_f8f6f4(Bt[n], At[m], acc[ai][bj][m][n], 0, 0, 0, 0x7F7F7F7F, 0, 0x7F7F7F7F); \
        } else { _Pragma("unroll") for (int k = 0; k < 2; ++k) { \
            if constexpr (Spec::FP8) { const l64x2 b2_ = __builtin_bit_cast(l64x2, G8_HALF(Bt[n], k)), a2_ = __builtin_bit_cast(l64x2, G8_HALF(At[m], k)); \
                acc[ai][bj][m][n] = __builtin_amdgcn_mfma_f32_16x16x32_fp8_fp8(b2_[0], a2_[0], acc[ai][bj][m][n], 0, 0, 0); \
                acc[ai][bj][m][n] = __builtin_amdgcn_mfma_f32_16x16x32_fp8_fp8(b2_[1], a2_[1], acc[ai][bj][m][n], 0, 0, 0); } \
            else acc[ai][bj][m][n] = __builtin_amdgcn_mfma_f32_16x16x32_bf16(G8_HALF(Bt[n], k), G8_HALF(At[m], k), acc[ai][bj][m][n], 0, 0, 0); } } } __builtin_amdgcn_s_setprio(0); } while (0)
#define G8_WAIT_V(n) asm volatile("s_waitcnt vmcnt(" #n ")" ::: "memory")
#define G8_WAIT_L(n) asm volatile("s_waitcnt lgkmcnt(" #n ")" ::: "memory")
#define G8_BAR __builtin_amdgcn_s_barrier()
#define G8_SCHED __builtin_amdgcn_sched_barrier(0)
    f32x4 acc[2][2][4][2];
#pragma unroll
    for (int a = 0; a < 2; ++a)
#pragma unroll
        for (int b = 0; b < 2; ++b)
#pragma unroll
            for (int m = 0; m < 4; ++m)
#pragma unroll
                for (int n = 0; n < 2; ++n) acc[a][b][m][n] = (f32x4){0.f, 0.f, 0.f, 0.f};
    i32x8 At[4], B0[2], B1[2];
    constexpr bool GATHER = Spec::GATHER;
    unsigned voffA[2][2];
    constexpr size_t hstepA = GATHER ? 0 : (size_t)128 * Spec::APITCH * 2;
    const char* cA; int ui = 0;
    if constexpr (GATHER) {
        const u32x4 o = *(const u32x4*)S.goff(0);
        voffA[0][0] = o[0]; voffA[0][1] = o[1]; voffA[1][0] = o[2]; voffA[1][1] = o[3];
        cA = S.a_base();
    } else {
#pragma unroll
        for (int i = 0; i < 2; ++i) { voffA[0][i] = (unsigned)(sR[i] * Spec::APITCH + sC[i]) * 2u; voffA[1][i] = voffA[0][i]; }
        cA = S.a_tile(u);
    }
    const char* cB = S.b_tile(u);
    G8_STAGE(G8_SB(0, 0), cB, voffB); G8_STAGE(G8_SB(0, 1), cB + hstepB, voffB); G8_STAGE(G8_SA(0, 0), cA, voffA[0]); G8_STAGE(G8_SA(0, 1), cA + hstepA, voffA[1]);
    if (wr == 1) G8_BAR;
    G8_WAIT_V(2); G8_BAR;
    G8_STAGE(G8_SB(1, 0), cB + kstep, voffB); G8_STAGE(G8_SA(1, 0), cA + kstep, voffA[0]); G8_STAGE(G8_SB(1, 1), cB + hstepB + kstep, voffB);
    G8_WAIT_V(6); G8_BAR;
    for (;;) {
        const int un = S.unit(ui + 1); const bool has_next = un >= 0;
        const char* nA; const char* nB = has_next ? S.b_tile(un) : cB;
        if constexpr (GATHER) { nA = cA;
            if (has_next) __builtin_amdgcn_global_load_lds((const __attribute__((address_space(1))) unsigned*)S.goff(ui + 1), (LAS unsigned*)(lds + GOFF_LDS + ldsw), 16, 0, 0);
        } else nA = has_next ? S.a_tile(un) : cA;
#pragma unroll 1
        for (int t = 0; t < NKT; t += 2) {
            const bool last = (t == NKT - 2);
            const char* a1 = cA + (size_t)(t + 1) * kstep;
            const char* a2 = last ? nA : cA + (size_t)(t + 2) * kstep; const char* b2 = last ? nB : cB + (size_t)(t + 2) * kstep;
            const char* a3 = a2 + kstep; const char* b3 = b2 + kstep;
            G8_LDB(B0, 0, 0); G8_LDB(B1, 0, 1); G8_SCHED; G8_LDA(At, 0, 0); G8_STAGE(G8_SA(1, 1), a1 + hstepA, voffA[1]);
            if constexpr (GATHER) { if (last && has_next) { const u32x4 o = *(const LAS u32x4*)(lds + GOFF_LDS + tid * 16);
                voffA[0][0] = o[0]; voffA[0][1] = o[1]; voffA[1][0] = o[2]; voffA[1][1] = o[3]; } }
            G8_WAIT_V(8); G8_WAIT_L(0); G8_BAR; G8_MMA(0, 0, At, B0); G8_MMA(0, 1, At, B1); G8_BAR; G8_SCHED;
            G8_LDA(At, 0, 1); G8_STAGE(G8_SB(0, 0), b2, voffB); G8_STAGE(G8_SB(0, 1), b2 + hstepB, voffB); G8_STAGE(G8_SA(0, 0), a2, voffA[0]);
            G8_WAIT_V(8); G8_WAIT_L(0); G8_BAR; G8_MMA(1, 0, At, B0); G8_MMA(1, 1, At, B1); G8_BAR; G8_SCHED;
            G8_LDB(B0, 1, 0); G8_LDB(B1, 1, 1); G8_SCHED; G8_LDA(At, 1, 0); G8_STAGE(G8_SA(0, 1), a2 + hstepA, voffA[1]);
            G8_WAIT_V(8); G8_WAIT_L(0); G8_BAR; G8_MMA(0, 0, At, B0); G8_MMA(0, 1, At, B1); G8_BAR; G8_SCHED;
            G8_LDA(At, 1, 1); G8_STAGE(G8_SB(1, 0), b3, voffB); G8_STAGE(G8_SB(1, 1), b3 + hstepB, voffB); G8_STAGE(G8_SA(1, 0), a3, voffA[0]);
            G8_WAIT_V(8); G8_WAIT_L(0); G8_BAR; G8_MMA(1, 0, At, B0); G8_MMA(1, 1, At, B1); G8_BAR; G8_SCHED;
        }
        if constexpr (Spec::ALIGN) { if (wr == 0) G8_BAR; }
        { const int le_ = ltid() & 63; S.epi(u, acc, wr, wc, le_ & 15, le_ >> 4); }
        if (!has_next) break;
#pragma unroll
        for (int a = 0; a < 2; ++a)
#pragma unroll
            for (int b = 0; b < 2; ++b)
#pragma unroll
                for (int m = 0; m < 4; ++m)
#pragma unroll
                    for (int n = 0; n < 2; ++n) acc[a][b][m][n] = (f32x4){0.f, 0.f, 0.f, 0.f};
        u = un; cA = nA; cB = nB; ++ui;
        if constexpr (Spec::ALIGN) { if (wr == 1) G8_BAR; }
    }
    G8_WAIT_V(0);
    if constexpr (!Spec::ALIGN) { if (wr == 0) G8_BAR; }
    G8_BAR;
#undef G8_SA
#undef G8_SB
#undef G8_STAGE
#undef G8_LDA
#undef G8_LDB
#undef G8_MMA
#undef G8_HALF
#undef G8_WAIT_V
#undef G8_WAIT_L
#undef G8_BAR
#undef G8_SCHED
}

template <bool RM = false>
DEVI void g8_store_bf16(const f32x4 (&acc)[2][2][4][2], bf16_t* out  , size_t ld, int wr, int wc, int fr, int fq, float scale = 1.f) {
    asm volatile("" : "+v"(fr), "+v"(fq));
#pragma unroll
    for (int ai = 0; ai < 2; ++ai)
#pragma unroll
        for (int m = 0; m < 4; ++m) { bf16_t* rowp = out + (size_t)(ai * 128 + wr * 64 + m * 16 + fr) * ld + wc * (RM ? 64 : 32) + 8 * fq;
#pragma unroll
            for (int bj = 0; bj < 2; ++bj) { const f32x4 v0 = acc[ai][bj][m][0] * scale, v1 = acc[ai][bj][m][1] * scale;
                u32x4 w = {pk2(v0[0], v0[1]), pk2(v0[2], v0[3]), pk2(v1[0], v1[1]), pk2(v1[2], v1[3])};
                *(u32x4*)(rowp + bj * (RM ? 32 : 128)) = w; } }
}

struct Outproj8 {
    static constexpr int K = 1024, APITCH = 1024, BPITCH = 1024; static constexpr bool GATHER = false, ALIGN = true, FP8 = false, MX = false, REMAP = false;
    const Params& p; int l; int nmt;
    DEVI int count() const { return nmt * 4; }
    DEVI int unit(int k) const { const int u = blockIdx.x + k * (int)gridDim.x; return u < count() ? u : -1; }
    DEVI const char* a_tile(int u) const { return p.ws + OFF_MIXIN + (size_t)(u >> 2) * 256 * 1024 * 2; }
    DEVI const char* b_tile(int u) const { return p.ws + OFF_WOUT + ((size_t)l * 1024 + (u & 3) * 256) * 1024 * 2; }
    DEVI void epi(int u, const f32x4 (&acc)[2][2][4][2], int wr, int wc, int fr, int fq) const {
        g8_store_bf16(acc, (bf16_t*)(p.ws + OFF_MIX) + (size_t)(u >> 2) * 256 * 1024 + (u & 3) * 256, 1024, wr, wc, fr, fq);
    }
};

struct OutprojCtx8 {
    static constexpr int K = 256, APITCH = 1024, BPITCH = 1024; static constexpr bool GATHER = false, ALIGN = false, FP8 = false, MX = false, REMAP = false;
    const Params& p; int l;
    DEVI int count() const { return 128; }
    DEVI int unit(int k) const { const int u = blockIdx.x + k * (int)gridDim.x; return u < 128 ? u : -1; }
    DEVI const char* a_tile(int u) const { return p.ws + OFF_MIXIN + ((size_t)(T_LAT / 256 + (u >> 4)) * 256 * 1024 + (u & 3) * 256) * 2; }
    DEVI const char* b_tile(int u) const { return p.ws + OFF_WOUT + (((size_t)l * 1024 + ((u >> 2) & 3) * 256) * 1024 + (u & 3) * 256) * 2; }
    DEVI void epi(int u, const f32x4 (&acc)[2][2][4][2], int wr, int wc, int fr, int fq) const {
        g8_store_bf16(acc, (bf16_t*)(p.ws + OFF_MIXC) + ((size_t)(u & 3) * T_CTX + (size_t)(u >> 4) * 256) * 1024 + ((u >> 2) & 3) * 256, 1024, wr, wc, fr, fq);
    }
};

struct Inproj8 {
    static constexpr int K = 1024, APITCH = 1024, BPITCH = 1024; static constexpr bool GATHER = false, ALIGN = true, FP8 = false, MX = false, REMAP = false;
    const Params& p; int l; lchar* lds;
    DEVI int count() const { return (T_ALL / 256) * 10; }
    DEVI int unit(int k) const { const int u = blockIdx.x + k * (int)gridDim.x; return u < count() ? u : -1; }
    DEVI const char* a_tile(int u) const { return p.ws + OFF_H + (size_t)(u / 10) * 256 * 1024 * 2; }
    DEVI const char* b_tile(int u) const { return p.ws + OFF_WIN + ((size_t)l * NP + (u % 10) * 256) * 1024 * 2; }
    DEVI void epi(int u, f32x4 (&acc)[2][2][4][2], int wr, int wc, int fr, int fq) const {
        asm volatile("" : "+v"(fr), "+v"(fq));
        const int pm = u / 10, pn = u % 10;
        const bool lat = pm < (T_LAT / 256);
        const float SA = 0.125f * LOG2E, SB = 0.10206207261596577f * LOG2E;
        LAS float* P = (LAS float*)(lds + GOFF_LDS);
        if (pn < 2 || pn == 3) {
#pragma unroll
            for (int bj = 0; bj < 2; ++bj)
#pragma unroll
                for (int ai = 0; ai < 2; ++ai)
#pragma unroll
                    for (int m = 0; m < 4; ++m) {
                        float ss = 0.f;
#pragma unroll
                        for (int n = 0; n < 2; ++n)
#pragma unroll
                            for (int j = 0; j < 4; ++j) ss += acc[ai][bj][m][n][j] * acc[ai][bj][m][n][j];
                        ss = rows_sum(ss);
                        if (fq == 0) P[((ai * 128 + wr * 64 + m * 16 + fr) * 2 + bj) * 4 + wc] = ss;
                    }
            asm volatile("s_waitcnt lgkmcnt(0)" ::: "memory"); __builtin_amdgcn_s_barrier(); asm volatile("" ::: "memory");
        }
#pragma unroll
        for (int bj = 0; bj < 2; ++bj) {
            const int g = 4 * pn + 2 * bj + (wc >> 1), hf = wc & 1;
            const int rope = ((g < 6) || (g >= 16 && g < 22)) ? 1 : ((g == 12 || g == 13 || g == 36) ? 2 : 0);
            const float scale = ((g < 4) || (g >= 16 && g < 20) || (g >= 24 && g < 28)) ? SA : ((g >= 8 && g < 14) ? SB : 1.f);
            if (g < 6) {
                const float* gn = (g < 4 ? p.a_q_norm : p.a_k_norm) + l * 64 + hf * 32 + 4 * fq;
                const float4 g0 = *(const float4*)gn, g1 = *(const float4*)(gn + 16);
                const float gv[2][4] = {{g0.x, g0.y, g0.z, g0.w}, {g1.x, g1.y, g1.z, g1.w}};
#pragma unroll
                for (int ai = 0; ai < 2; ++ai)
#pragma unroll
                    for (int m = 0; m < 4; ++m) {
                        const int row = ai * 128 + wr * 64 + m * 16 + fr;
                        const float ss = P[(row * 2 + bj) * 4 + wc] + P[(row * 2 + bj) * 4 + (wc ^ 1)];
                        const float rs = rsqrtf(ss * (1.f / 64.f) + EPS);
#pragma unroll
                        for (int n = 0; n < 2; ++n)
#pragma unroll
                            for (int j = 0; j < 4; ++j) acc[ai][bj][m][n][j] *= rs * gv[n][j];
                    }
            }
            if (g == 14 || g == 15) {
#pragma unroll
                for (int ai = 0; ai < 2; ++ai)
#pragma unroll
                    for (int m = 0; m < 4; ++m) {
                        const int row = ai * 128 + wr * 64 + m * 16 + fr;
                        const f32x4 ps = *(const LAS f32x4*)(P + (row * 2 + bj) * 4);
                        const float rs = rsqrtf((ps[0] + ps[1] + ps[2] + ps[3]) * (1.f / 128.f) + EPS);
#pragma unroll
                        for (int n = 0; n < 2; ++n) acc[ai][bj][m][n] *= rs;
                    }
            }
            if (rope != 0 && lat) {
                const float* tab = (const float*)(p.ws + (rope == 1 ? OFF_TABH : OFF_TABR));
                const int tw = rope == 1 ? 32 : 16, a0 = (rope == 1 ? hf * 16 : 0) + fq * 4;
#pragma unroll
                for (int ai = 0; ai < 2; ++ai)
#pragma unroll
                    for (int m = 0; m < 4; ++m) {
                        const int pos = (pm * 256 + ai * 128 + wr * 64 + m * 16 + fr) & 2047;
                        const float4 t0 = *(const float4*)(tab + ((size_t)pos * tw + a0) * 2), t1 = *(const float4*)(tab + ((size_t)pos * tw + a0) * 2 + 4);
                        const float cs[4] = {t0.x, t0.z, t1.x, t1.z}, sn[4] = {t0.y, t0.w, t1.y, t1.w};
#pragma unroll
                        for (int j = 0; j < 4; ++j) {
                            const float x1 = acc[ai][bj][m][0][j], x2 = acc[ai][bj][m][1][j];
                            acc[ai][bj][m][0][j] = x1 * cs[j] - x2 * sn[j];
                            acc[ai][bj][m][1][j] = x2 * cs[j] + x1 * sn[j];
                        }
                        if (m & 1) __builtin_amdgcn_sched_barrier(0);
                    }
            }
            bf16_t* out = (bf16_t*)(p.ws + OFF_P) + (size_t)pm * 256 * NP + pn * 256 + bj * 128 + wc * 32 + 8 * fq;
#pragma unroll
            for (int ai = 0; ai < 2; ++ai)
#pragma unroll
                for (int m = 0; m < 4; ++m) {
                    const f32x4 v0 = acc[ai][bj][m][0] * scale, v1 = acc[ai][bj][m][1] * scale;
                    u32x4 w = {pk2(v0[0], v0[1]), pk2(v0[2], v0[3]), pk2(v1[0], v1[1]), pk2(v1[2], v1[3])};
                    *(u32x4*)(out + (size_t)(ai * 128 + wr * 64 + m * 16 + fr) * NP) = w;
                }
        }
    }
};

struct Kvup8 {
    static constexpr int K = 128, APITCH = NP, BPITCH = 128; static constexpr bool GATHER = false, ALIGN = false, FP8 = false, MX = false, REMAP = false;
    const Params& p; int l;
    DEVI int count() const { return (T_ALL / 256) * 2; }
    DEVI int unit(int k) const { const int u = blockIdx.x + k * (int)gridDim.x; return u < count() ? u : -1; }
    DEVI const char* a_tile(int u) const { return p.ws + OFF_P + ((size_t)(u >> 1) * 256 * NP + PC_CKV) * 2; }
    DEVI const char* b_tile(int u) const { return p.ws + OFF_WKV + ((size_t)l * 512 + (u & 1) * 256) * 128 * 2; }
    DEVI void epi(int u, const f32x4 (&acc)[2][2][4][2], int wr, int wc, int fr, int fq) const {
        g8_store_bf16(acc, (bf16_t*)(p.ws + OFF_KVB) + (size_t)(u >> 1) * 256 * NKV + (u & 1) * 256, NKV, wr, wc, fr, fq);
    }
};

struct Gateup8 {
    static constexpr int K = 512, APITCH = 512, BPITCH = 512; static constexpr bool GATHER = true, ALIGN = true, FP8 = true, MX = true, REMAP = false;
    const Params& p; lchar* lds; int nmt_r, nmt_sh;
    DEVI int count() const { return (nmt_r + nmt_sh) * 2; }
    DEVI int unit(int k) const {
        const int nmt = nmt_r + nmt_sh, NQ = (int)gridDim.x >> 3, x = blockIdx.x & 7, q = blockIdx.x >> 3, R = (nmt + 7) >> 3;
        if ((gridDim.x & 7) != 0) { const int u = blockIdx.x + k * (int)gridDim.x; return u < count() ? u : -1; }
        const int idx = k * NQ + q, mtl = idx >> 1, mt = x * R + mtl;
        return (mtl < R && mt < nmt) ? mt * 2 + (idx & 1) : -1;
    }
    DEVI const char* a_base() const { return p.ws + OFF_H; }
    DEVI const char* a_tile(int) const { return p.ws + OFF_H; }
    DEVI const char* goff(int k) const { const char* b = p.ws + OFF_GOFF + ((size_t)blockIdx.x * 8 + k) * 8192; asm volatile("" : "+s"(b)); return b + ltid() * 16; }
    DEVI const char* b_tile(int u) const {
        const int mt = u >> 1, e = mt >= nmt_r ? 64 : __builtin_amdgcn_readfirstlane(seg_expert(lds, mt * 256));
        return p.ws + OFF_WGU + ((size_t)e * 512 + (u & 1) * 256) * 1024;
    }
    DEVI void epi(int u, const f32x4 (&acc)[2][2][4][2], int wr, int wc, int fr, int fq) const {
        const int mt = u >> 1, row0 = mt >= nmt_r ? SH_BASE + (mt - nmt_r) * 256 : mt * 256;
        unsigned char* out = (unsigned char*)(p.ws + OFF_ACT) + (size_t)row0 * 256 + (u & 1) * 128 + wc * 32 + (fq & ~1) * 8 + (size_t)((fq & 1) * 16) * 256;
#pragma unroll
        for (int ai = 0; ai < 2; ++ai)
#pragma unroll
            for (int mp = 0; mp < 4; mp += 2) {
                unsigned w[2][2];
#pragma unroll
                for (int mm = 0; mm < 2; ++mm) {
                    const int m = mp + mm;
                    float a[8];
#pragma unroll
                    for (int n = 0; n < 2; ++n)
#pragma unroll
                        for (int j = 0; j < 4; ++j) a[n * 4 + j] = fminf(fmaxf(silu_f(acc[ai][0][m][n][j] * (1.f / (H2_SCALE * WGU_SCALE))) * acc[ai][1][m][n][j] * (ACT_SCALE / (H2_SCALE * WGU_SCALE)), -448.f), 448.f);
                    int w0 = __builtin_amdgcn_cvt_pk_fp8_f32(a[0], a[1], 0, false); w0 = __builtin_amdgcn_cvt_pk_fp8_f32(a[2], a[3], w0, true);
                    int w1 = __builtin_amdgcn_cvt_pk_fp8_f32(a[4], a[5], 0, false); w1 = __builtin_amdgcn_cvt_pk_fp8_f32(a[6], a[7], w1, true);
                    w[mm][0] = (unsigned)w0; w[mm][1] = (unsigned)w1;
                }
                const auto r0 = __builtin_amdgcn_permlane16_swap(w[0][0], w[1][0], false, false), r1 = __builtin_amdgcn_permlane16_swap(w[0][1], w[1][1], false, false);
                *(u32x4*)(out + (size_t)(ai * 128 + wr * 64 + mp * 16 + fr) * 256) = (u32x4){r0[0], r1[0], r0[1], r1[1]};
            }
    }
};
template <class Spec> DEVI void build_goff(const Params& p, int nmt_r, const Spec& S) {
    const int tid = ltid();
    int sR[2], sC[2];
#pragma unroll
    for (int i = 0; i < 2; ++i) stage_rc(tid * 16 + i * 8192, sR[i], sC[i]);
    const int* stk = (const int*)(p.ws + OFF_STK);
    u32x4* tab = (u32x4*)(p.ws + OFF_GOFF) + (size_t)blockIdx.x * 8 * 512 + tid;
    u32x4 o[8];
#pragma unroll
    for (int k = 0; k < 8; ++k) {
        const int u = S.unit(k); const int mt = u >> 1;
#pragma unroll
        for (int h = 0; h < 2; ++h)
#pragma unroll
            for (int i = 0; i < 2; ++i) { const int row = h * 128 + sR[i]; const int tok = u < 0 ? 0 : mt >= nmt_r ? (mt - nmt_r) * 256 + row : stk[mt * 256 + row];
                o[k][h * 2 + i] = (unsigned)(tok * 512 + sC[i]) * 2u; }
    }
#pragma unroll
    for (int k = 0; k < 8; ++k) if (S.unit(k) >= 0) tab[(size_t)k * 512] = o[k];
    asm volatile("s_waitcnt vmcnt(0)" ::: "memory");
    __syncthreads();
}

struct Down8 {
    static constexpr int K = 128, APITCH = 128, BPITCH = 128; static constexpr bool GATHER = false, ALIGN = false, FP8 = true, MX = true, REMAP = true;
    const Params& p; lchar* lds; int nmt_r, nmt_sh;
    bool y8;
    DEVI int count() const { return (nmt_r + nmt_sh) * 4; }
    DEVI int unit(int k) const {
        const int nmt = nmt_r + nmt_sh, NQ = (int)gridDim.x >> 3, x = blockIdx.x & 7, q = blockIdx.x >> 3, R = (nmt + 7) >> 3;
        if ((gridDim.x & 7) != 0) { const int u = blockIdx.x + k * (int)gridDim.x; return u < count() ? u : -1; }
        const int idx = k * NQ + q, mtl = idx >> 2, mt = x * R + mtl;
        return (mtl < R && mt < nmt) ? mt * 4 + (idx & 3) : -1;
    }
    DEVI int row0(int mt) const { return mt >= nmt_r ? SH_BASE + (mt - nmt_r) * 256 : mt * 256; }
    DEVI const char* a_tile(int u) const { return p.ws + OFF_ACT + (size_t)row0(u >> 2) * 256; }
    DEVI const char* b_tile(int u) const {
        const int mt = u >> 2, e = mt >= nmt_r ? 64 : __builtin_amdgcn_readfirstlane(seg_expert(lds, mt * 256));
        return p.ws + OFF_WD + ((size_t)e * 1024 + (u & 3) * 256) * 256;
    }
    DEVI void epi(int u, const f32x4 (&acc)[2][2][4][2], int wr, int wc, int fr, int fq) const {
        const int mt = u >> 2;
        if (y8 && mt < nmt_r) {
            asm volatile("" : "+v"(fr), "+v"(fq));
            unsigned char* o8 = (unsigned char*)(p.ws + OFF_Y) + (size_t)mt * 256 * 1024 + (u & 3) * 256 + wc * 64 + (fq >> 1) * 16 + (fq & 1) * 32;
#pragma unroll
            for (int ai = 0; ai < 2; ++ai)
#pragma unroll
                for (int m = 0; m < 4; ++m) {
                    unsigned w[2][2];
#pragma unroll
                    for (int bj = 0; bj < 2; ++bj) {
                        f32x4 v0 = acc[ai][bj][m][0] * (64.f / (ACT_SCALE * WD_SCALE)), v1 = acc[ai][bj][m][1] * (64.f / (ACT_SCALE * WD_SCALE));
#pragma unroll
                        for (int q = 0; q < 4; ++q) { v0[q] = fminf(fmaxf(v0[q], -448.f), 448.f); v1[q] = fminf(fmaxf(v1[q], -448.f), 448.f); }
                        int w0 = __builtin_amdgcn_cvt_pk_fp8_f32(v0[0], v0[1], 0, false); w0 = __builtin_amdgcn_cvt_pk_fp8_f32(v0[2], v0[3], w0, true);
                        int w1 = __builtin_amdgcn_cvt_pk_fp8_f32(v1[0], v1[1], 0, false); w1 = __builtin_amdgcn_cvt_pk_fp8_f32(v1[2], v1[3], w1, true);
                        w[bj][0] = (unsigned)w0; w[bj][1] = (unsigned)w1;
                    }
                    const auto r0 = __builtin_amdgcn_permlane16_swap(w[0][0], w[1][0], false, false), r1 = __builtin_amdgcn_permlane16_swap(w[0][1], w[1][1], false, false);
                    *(u32x4*)(o8 + (size_t)(ai * 128 + wr * 64 + m * 16 + fr) * 1024) = (u32x4){r0[0], r1[0], r0[1], r1[1]};
                }
            return;
        }
        bf16_t* out = mt >= nmt_r ? (bf16_t*)(p.ws + OFF_H) + (size_t)(mt - nmt_r) * 256 * 1024 : (bf16_t*)(p.ws + OFF_Y) + (size_t)mt * 256 * 1024;
        g8_store_bf16<true>(acc, out + (u & 3) * 256, 1024, wr, wc, fr, fq, 1.f / (ACT_SCALE * WD_SCALE));
    }
};

DEVI Params ldp() {
#if defined(__HIP_DEVICE_COMPILE__)
    const __attribute__((address_space(4))) Params* kp = (const __attribute__((address_space(4))) Params*)__builtin_amdgcn_kernarg_segment_ptr();
    asm volatile("" : "+s"(kp));
    return *kp;
#else
    return Params{};
#endif
}
constexpr int CB_OFF = 124928, CB_GRP = 1040, CB_BUF = 16 * CB_GRP;
constexpr int NCHUNK = 65 * 192;
constexpr int CD_OFF = CB_OFF + 2 * CB_BUF, CD_MAX = 52;
static_assert(CD_OFF + CD_MAX * 32 <= LDS_XB, "chunk descriptor table");
struct ConvRide { int j, nj, pend; };
struct CChunk { const float* src; int stride; bf16_t* dst; int K; };
DEVI CChunk cchunk(const Params& p, int l, int c) {
    const int e = c / 192, r = c - e * 192;
    CChunk d;
    if (r < 128) {
        const int blk = r >> 4, kb = r & 15, nt = blk >> 2, hf = (blk >> 1) & 1, c0 = (blk & 1) * 64;
        const float* g = e < 64 ? p.exp_w_gate + ((size_t)l * 64 + e) * 1024 * 256 : p.sh_w_gate + (size_t)l * 1024 * 256;
        const float* u = e < 64 ? p.exp_w_up + ((size_t)l * 64 + e) * 1024 * 256 : p.sh_w_up + (size_t)l * 1024 * 256;
        d.src = (hf ? u : g) + nt * 128 + c0 + (size_t)kb * 64 * 256; d.stride = 256;
        d.dst = (bf16_t*)(p.ws + OFF_WGU + ((size_t)e * 512 + blk * 64) * 1024 + kb * 64); d.K = 1024 | 0x20000;
    } else {
        const int rr = r - 128, nb = rr >> 2, kb = rr & 3;
        const float* dn = e < 64 ? p.exp_w_down + ((size_t)l * 64 + e) * 256 * 1024 : p.sh_w_down + (size_t)l * 256 * 1024;
        d.src = dn + nb * 64 + (size_t)kb * 64 * 1024; d.stride = 1024;
        d.dst = (bf16_t*)(p.ws + OFF_WD + ((size_t)e * 1024 + nb * 64) * 256 + kb * 64); d.K = 256 | 0x10000;
    }
    return d;
}
DEVI void cride_table(lchar* lds, const Params& p, int l, int base, int n) {
    const int t = ltid();
    if (t < n) {
        const CChunk d = cchunk(p, l, blockIdx.x + (base + t) * gridDim.x);
        const unsigned long long sa = (unsigned long long)d.src, da = (unsigned long long)d.dst;
        *(LAS u32x4*)(lds + CD_OFF + t * 32) = (u32x4){(unsigned)sa, (unsigned)(sa >> 32), (unsigned)da, (unsigned)(da >> 32)};
        *(LAS u32x2*)(lds + CD_OFF + t * 32 + 16) = (u32x2){(unsigned)d.stride * 4u, (unsigned)d.K};
    }
    __syncthreads();
}
DEVI void cride_entry(lchar* lds, int j, u32x4& e0, u32x2& e1) {
    const unsigned a = (unsigned)(__UINTPTR_TYPE__)(lds + CD_OFF) + (unsigned)j * 32u;
    asm volatile("ds_read_b128 %0, %2\n\tds_read_b64 %1, %2 offset:16\n\ts_waitcnt lgkmcnt(0)" : "=&v"(e0), "=&v"(e1) : "v"(a) : "memory");
}
DEVI void cride_issue(lchar* lds, int j, int boff) {
    const int tid = ltid(), w = __builtin_amdgcn_readfirstlane(tid >> 6), lane = tid & 63;
    u32x4 e0; u32x2 e1; cride_entry(lds, j, e0, e1);
    const unsigned long long sa = ((unsigned long long)e0[1] << 32) | e0[0];
    const char* g = (const char*)sa + (size_t)((unsigned)(w * 4 + (lane >> 4)) * e1[0]) + (lane & 15) * 16;
    lchar* dl = lds + boff + w * CB_GRP;
    __builtin_amdgcn_global_load_lds((const __attribute__((address_space(1))) unsigned*)g, (LAS unsigned*)dl, 16, 0, 2);
    __builtin_amdgcn_global_load_lds((const __attribute__((address_space(1))) unsigned*)(g + (size_t)(32u * e1[0])), (LAS unsigned*)(dl + 8 * CB_GRP), 16, 0, 2);
}
DEVI void cride_consume(lchar* lds, int j, int boff) {
    const int tid = ltid(), w = tid >> 6, lane = tid & 63, nl = w * 8 + (lane >> 3), kc = lane & 7;
    u32x4 e0; u32x2 e1; cride_entry(lds, j, e0, e1);
    const unsigned a = (unsigned)(__UINTPTR_TYPE__)(lds + boff + kc * 2 * CB_GRP + nl * 4);
    float v0, v1, v2, v3, v4, v5, v6, v7;
    asm volatile("ds_read_b32 %0, %8\n\tds_read_b32 %1, %8 offset:256\n\tds_read_b32 %2, %8 offset:512\n\tds_read_b32 %3, %8 offset:768\n\t"
                 "ds_read_b32 %4, %8 offset:1040\n\tds_read_b32 %5, %8 offset:1296\n\tds_read_b32 %6, %8 offset:1552\n\tds_read_b32 %7, %8 offset:1808\n\ts_waitcnt lgkmcnt(0)"
                 : "=&v"(v0), "=&v"(v1), "=&v"(v2), "=&v"(v3), "=&v"(v4), "=&v"(v5), "=&v"(v6), "=&v"(v7) : "v"(a) : "memory");
    const unsigned K = e1[1] & 0xffffu;
    if (e1[1] >> 16) {
        float v[8] = {v0, v1, v2, v3, v4, v5, v6, v7};
        const float wsc = (e1[1] >> 17) ? WGU_SCALE : WD_SCALE;
#pragma unroll
        for (int i = 0; i < 8; ++i) v[i] = fminf(fmaxf(v[i] * wsc, -448.f), 448.f);
        int w0 = __builtin_amdgcn_cvt_pk_fp8_f32(v[0], v[1], 0, false); w0 = __builtin_amdgcn_cvt_pk_fp8_f32(v[2], v[3], w0, true);
        int w1 = __builtin_amdgcn_cvt_pk_fp8_f32(v[4], v[5], 0, false); w1 = __builtin_amdgcn_cvt_pk_fp8_f32(v[6], v[7], w1, true);
        unsigned char* dst = (unsigned char*)(((unsigned long long)e0[3] << 32) | e0[2]);
        __builtin_nontemporal_store((u32x2){(unsigned)w0, (unsigned)w1}, (__attribute__((address_space(1))) u32x2*)(dst + (size_t)((unsigned)nl * K) + kc * 8));
    } else {
        const u32x4 w4 = {pk2(v0, v1), pk2(v2, v3), pk2(v4, v5), pk2(v6, v7)};
        bf16_t* dst = (bf16_t*)(((unsigned long long)e0[3] << 32) | e0[2]);
        *(__attribute__((address_space(1))) u32x4*)(dst + (size_t)((unsigned)nl * K) + kc * 8) = w4;
    }
}
DEVI int cride_boff(int j) { return CB_OFF + (j & 1) * CB_BUF; }
DEVI void cride_step(lchar* lds, ConvRide& cr) {
    const bool cnew = cr.j < cr.nj;
    if (cnew) cride_issue(lds, cr.j, cride_boff(cr.j));
    if (cr.pend >= 0) cride_consume(lds, cr.pend, cride_boff(cr.pend));
    cr.pend = cnew ? cr.j : -1; cr.j += cnew ? 1 : 0;
}

typedef short v4i16 __attribute__((ext_vector_type(4)));
template <int MODE> constexpr int attn_slot_bytes() { return 128 * 128 + (MODE == 1 ? 128 * 64 : 0) + 128 * 128; }
template <int MODE> DEVI int attn_ntile(int qi, bool ctxq) {
    constexpr int NCT = CTXL / 128;
    if (ctxq) return NCT;
    if (MODE == 0 || MODE == 1) return NCT + SEQ / 128;
    if (MODE == 2) { const int k0 = max(0, qi * 256 - 128), k1 = min(SEQ, qi * 256 + 384); return NCT + (k1 - k0) / 128; }
    const int rs = min(max(4 * qi - 4, 0), 24), rs3 = min(max(4 * qi + 3 - 4, 0), 24); return NCT + ((rs3 + 8 - rs + 1) >> 1);
}
template <int MODE>
DEVI void attn_pre(lchar* lds, const Params& p, int b, int h) {
    constexpr int TK = 128, KMB = TK * 128, KRB = MODE == 1 ? TK * 64 : 0;
    const int tid = ltid(), wid = tid >> 6;
    const bf16_t* P = (const bf16_t*)(p.ws + OFF_P);
    const bf16_t* KVB = (const bf16_t*)(p.ws + OFF_KVB);
    const int kcol = MODE == 0 ? PC_AK + (h >> 1) * 64 : MODE == 2 ? PC_CK + (h >> 1) * 64 : PC_DK + h * 64;
    const int vcol = MODE == 0 ? PC_AV + (h >> 1) * 64 : MODE == 2 ? PC_CV + (h >> 1) * 64 : PC_DV + h * 64;
    constexpr unsigned PITCH = MODE == 1 ? NKV * 2 : NP * 2;
    unsigned goff[2], groff = 0;
#pragma unroll
    for (int i = 0; i < 2; ++i) { const int bb = i * 8192 + tid * 16, r = bb >> 7, c = ((bb >> 4) & 7) ^ (r & 7); goff[i] = (unsigned)r * PITCH + (unsigned)c * 16u; }
    if (MODE == 1) { const int bb = tid * 16, r = bb >> 6, c = ((bb >> 4) & 3) ^ ((r ^ (r >> 2)) & 3); groff = (unsigned)r * (NP * 2) + (unsigned)c * 16u; }
    const char* kbase0 = MODE == 1 ? (const char*)KVB + h * 256 : (const char*)P + kcol * 2;
    const char* vbase0 = MODE == 1 ? (const char*)KVB + h * 256 + 128 : (const char*)P + vcol * 2;
    const unsigned ldsw = (unsigned)__builtin_amdgcn_readfirstlane(wid) * 1024u;
    const size_t r0 = (size_t)(T_LAT + b * CTXL);
    const char* kb_ = kbase0 + r0 * PITCH; const char* vb_ = vbase0 + r0 * PITCH;
    lchar* sl = lds + ldsw;
#pragma unroll
    for (int i = 0; i < 2; ++i) glds16(kb_ + goff[i], sl + i * 8192);
    if (MODE == 1) glds16((const char*)P + (r0 * NP + PC_BKR) * 2 + groff, sl + KMB);
#pragma unroll
    for (int i = 0; i < 2; ++i) glds16(vb_ + goff[i], sl + KMB + KRB + i * 8192);
}
template <int MODE>
DEVI void attn_unit(lchar* lds, const Params& p, int l, int b, int h, int qi, bool ctxq, ConvRide& cr, bool pre0, int nx, int nb = -1, int nh = -1) {
    constexpr int TK = 128, NKB = TK / 16, NKK = TK / 32, NCT = CTXL / TK;
    constexpr int DK = MODE == 1 ? 96 : 64, QG = 2, KS = DK * 2 + 16, VS = 144, NKS = DK / 32;
    constexpr int NSLOT = 3, KMB = TK * 128, KRB = MODE == 1 ? TK * 64 : 0, VBY = TK * 128, SLOT = KMB + KRB + VBY, OFFB = NSLOT * SLOT;
    constexpr int NLD = MODE == 1 ? 5 : 4;
    static_assert(OFFB + 2048 <= CB_OFF, "attention LDS ring");
    const int tid = ltid(), wid = tid >> 6, lane = tid & 63, fr = lane & 15, fq = lane >> 4;
    const bf16_t* P = (const bf16_t*)(p.ws + OFF_P);
    const bf16_t* KVB = (const bf16_t*)(p.ws + OFF_KVB);
    const int qcol = MODE == 0 ? PC_AQ + h * 64 : MODE == 1 ? PC_BQN + h * 64 : MODE == 2 ? PC_CQ + h * 64 : PC_DQ + h * 64;
    const int kcol = MODE == 0 ? PC_AK + (h >> 1) * 64 : MODE == 2 ? PC_CK + (h >> 1) * 64 : PC_DK + h * 64;
    const int vcol = MODE == 0 ? PC_AV + (h >> 1) * 64 : MODE == 2 ? PC_CV + (h >> 1) * 64 : PC_DV + h * 64;
    const int ocol = MODE * 256 + h * 64;
    const int qrow0 = (ctxq ? T_LAT + b * CTXL : b * SEQ) + qi * (NW * QG * 16) + wid * (QG * 16);
    bf16x8 qf[QG][NKS];
#pragma unroll
    for (int g = 0; g < QG; ++g)
#pragma unroll
        for (int ks = 0; ks < NKS; ++ks) {
            const size_t row = (size_t)(qrow0 + g * 16 + fr);
            const bf16_t* ptr = (MODE == 1 && ks == 2) ? P + row * NP + PC_BQR + h * 32 + fq * 8 : P + row * NP + qcol + ks * 32 + fq * 8;
            qf[g][ks] = *(const bf16x8*)ptr;
        }
    int nlat = 0, lat0 = 0, rs = 0;
    if (!ctxq) {
        if (MODE == 0 || MODE == 1) { nlat = SEQ / TK; lat0 = 0; }
        else if (MODE == 2) { const int k0 = max(0, qi * 256 - 128), k1 = min(SEQ, qi * 256 + 384); nlat = (k1 - k0) / TK; lat0 = k0; }
        else { rs = min(max(4 * qi - 4, 0), 24); const int rs3 = min(max(4 * qi + 3 - 4, 0), 24); nlat = (rs3 + 8 - rs + 1) >> 1; lat0 = rs * 64; }
    }
    const int ntile = NCT + nlat;
    LAS float* btab = (LAS float*)(lds + OFFB);
    if (MODE == 3) { const float* rpb = p.d_rpb + (size_t)(l * 4 + h) * 465; for (int i = tid; i < 465; i += NT) btab[i] = rpb[i] * LOG2E; }
    constexpr float THR = 8.f;
    float mref[QG]; f32x4 o[QG][4], ol[QG];
#pragma unroll
    for (int g = 0; g < QG; ++g) {
        mref[g] = 0.f; ol[g] = (f32x4){0.f, 0.f, 0.f, 0.f};
        if (MODE == 2) { mref[g] = p.c_sink[l * 4 + h] * LOG2E; ol[g][0] = fq == 0 ? 1.f : 0.f; }
#pragma unroll
        for (int d = 0; d < 4; ++d) o[g][d] = (f32x4){0.f, 0.f, 0.f, 0.f};
    }
    const unsigned onesw = fr == 0 ? 0x3F803F80u : 0u;
    const bf16x8 vones = __builtin_bit_cast(bf16x8, (u32x4){onesw, onesw, onesw, onesw});
    auto tile_row = [&](int t) { return t < NCT ? T_LAT + b * CTXL + t * TK : b * SEQ + lat0 + (t - NCT) * TK; };
    unsigned goff[2], groff = 0;
    constexpr unsigned PITCH = MODE == 1 ? NKV * 2 : NP * 2;
#pragma unroll
    for (int i = 0; i < 2; ++i) { const int bb = i * 8192 + tid * 16, r = bb >> 7, c = ((bb >> 4) & 7) ^ (r & 7); goff[i] = (unsigned)r * PITCH + (unsigned)c * 16u; }
    if (MODE == 1) { const int bb = tid * 16, r = bb >> 6, c = ((bb >> 4) & 3) ^ ((r ^ (r >> 2)) & 3); groff = (unsigned)r * (NP * 2) + (unsigned)c * 16u; }
    const char* kbase0 = MODE == 1 ? (const char*)KVB + h * 256 : (const char*)P + kcol * 2;
    const char* vbase0 = MODE == 1 ? (const char*)KVB + h * 256 + 128 : (const char*)P + vcol * 2;
    const unsigned ldsw = (unsigned)__builtin_amdgcn_readfirstlane(wid) * 1024u;
#define ATT_GLDS(src, dst) __builtin_amdgcn_global_load_lds((const __attribute__((address_space(1))) unsigned*)(src), (LAS unsigned*)(dst), 16, 0, 0)
    auto issue_tile = [&](int t, auto slc) {
        constexpr int slot = decltype(slc)::value;
        const size_t r0 = (size_t)tile_row(t);
        const char* kb_ = kbase0 + r0 * PITCH; const char* vb_ = vbase0 + r0 * PITCH;
        lchar* sl = lds + slot * SLOT + ldsw;
#pragma unroll
        for (int i = 0; i < 2; ++i) ATT_GLDS(kb_ + goff[i], sl + i * 8192);
        if (MODE == 1) ATT_GLDS((const char*)P + (r0 * NP + PC_BKR) * 2 + groff, sl + KMB);
#pragma unroll
        for (int i = 0; i < 2; ++i) ATT_GLDS(vb_ + goff[i], sl + KMB + KRB + i * 8192);
    };
    const int kq7 = fr & 7;
    const int koffm = fr * 128;
    const int koffr = KMB + fr * 64 + ((fq ^ ((fr ^ (fr >> 2)) & 3)) << 4);
    const int vrow = 4 * fq + (fr >> 2), v7 = vrow & 7;
    const int voffb = KMB + KRB + vrow * 128 + (fr & 1) * 8;
    typedef std::integral_constant<int, 0> SL0; typedef std::integral_constant<int, 1> SL1; typedef std::integral_constant<int, 2> SL2;
    if (!pre0) issue_tile(0, SL0{});
    if (ntile > 1) issue_tile(1, SL1{});
    auto step = [&](int t, auto slc, auto isc) {
        constexpr int slot = decltype(slc)::value;
        if (t + 1 < ntile) { if (MODE == 1) asm volatile("s_waitcnt vmcnt(5) lgkmcnt(0)" ::: "memory"); else asm volatile("s_waitcnt vmcnt(4) lgkmcnt(0)" ::: "memory"); }
        else asm volatile("s_waitcnt vmcnt(0) lgkmcnt(0)" ::: "memory");
        __builtin_amdgcn_s_barrier();
        asm volatile("" ::: "memory");
        cride_step(lds, cr);
        const lchar* Sb = lds + slot * SLOT;
        f32x4 s[QG][NKB];
#pragma unroll
        for (int g = 0; g < QG; ++g)
#pragma unroll
            for (int kb = 0; kb < NKB; ++kb) s[g][kb] = (f32x4){-mref[g], -mref[g], -mref[g], -mref[g]};
#pragma unroll
        for (int kb = 0; kb < NKB; ++kb)
#pragma unroll
            for (int ks = 0; ks < NKS; ++ks) {
                const bf16x8 kf = (MODE == 1 && ks == 2) ? *(const LAS bf16x8*)(Sb + koffr + kb * 1024) : *(const LAS bf16x8*)(Sb + koffm + kb * 2048 + (((ks * 4 + fq) ^ kq7) << 4));
#pragma unroll
                for (int g = 0; g < QG; ++g) s[g][kb] = __builtin_amdgcn_mfma_f32_16x16x32_bf16(kf, qf[g][ks], s[g][kb], 0, 0, 0);
            }
        if (t >= NCT) {
            if (MODE == 2) {
                const int k0t = lat0 + (t - NCT) * TK;
#pragma unroll
                for (int g = 0; g < QG; ++g) { const int qpos = qi * 256 + wid * 32 + g * 16 + fr;
#pragma unroll
                    for (int kb = 0; kb < NKB; ++kb)
#pragma unroll
                        for (int j = 0; j < 4; ++j) { const int d = qpos - (k0t + kb * 16 + fq * 4 + j); if (d > 128 || d < -128) s[g][kb][j] = -1e30f; } }
            }
            if (MODE == 3) {
                const int myr = 4 * qi + (wid >> 1), myrs = min(max(myr - 4, 0), 24);
#pragma unroll
                for (int g = 0; g < QG; ++g) {
                    const int c = (wid & 1) * 32 + g * 16 + fr, cs = min(max(c - 8, 0), 48);
#pragma unroll
                    for (int kb = 0; kb < NKB; ++kb) {
                        const int krow = rs + 2 * (t - NCT) + (kb >> 2);
                        const bool rowok = (unsigned)(krow - myrs) < 8u;
                        const int brow = (krow - myr + 7) * 31;
#pragma unroll
                        for (int j = 0; j < 4; ++j) { const int kc = (kb & 3) * 16 + fq * 4 + j; const bool ok = rowok && (unsigned)(kc - cs) < 16u;
                            const float bv = btab[ok ? brow + kc - c + 15 : 0];
                            s[g][kb][j] = ok ? s[g][kb][j] + bv : -1e30f; }
                    }
                }
            }
        }
        bf16x8 pf[QG][NKK];
#pragma unroll
        for (int g = 0; g < QG; ++g) {
            float mx = s[g][0][0];
#pragma unroll
            for (int kb = 0; kb < NKB; ++kb)
#pragma unroll
                for (int j = 0; j < 4; ++j) mx = fmaxf(mx, s[g][kb][j]);
            mx = rows_max(mx);
            const bool first = MODE != 2 && t == 0;
            if (first || __any(mx > THR)) {
                const float d = first ? mx : fmaxf(mx, 0.f), alpha = fexp2(-d);
                mref[g] += d;
#pragma unroll
                for (int kb = 0; kb < NKB; ++kb)
#pragma unroll
                    for (int j = 0; j < 4; ++j) s[g][kb][j] -= d;
#pragma unroll
                for (int dd = 0; dd < 4; ++dd) o[g][dd] *= alpha;
                ol[g] *= alpha;
            }
#pragma unroll
            for (int kb = 0; kb < NKB; ++kb)
#pragma unroll
                for (int j = 0; j < 4; ++j) s[g][kb][j] = fexp2(s[g][kb][j]);
#pragma unroll
            for (int kk = 0; kk < NKK; ++kk) {
                const unsigned w0 = pk2(s[g][2 * kk][0], s[g][2 * kk][1]), w1 = pk2(s[g][2 * kk][2], s[g][2 * kk][3]);
                const unsigned w2 = pk2(s[g][2 * kk + 1][0], s[g][2 * kk + 1][1]), w3 = pk2(s[g][2 * kk + 1][2], s[g][2 * kk + 1][3]);
                const u32x4 w = {w0, w1, w2, w3};
                pf[g][kk] = __builtin_bit_cast(bf16x8, w);
            }
        }
        __builtin_amdgcn_sched_barrier(0);
        if (t + 2 < ntile) issue_tile(t + 2, isc);
        else if (t + 1 == ntile && nx != 0) { if (nx == 1) attn_pre<MODE>(lds, p, nb, nh); else attn_pre<(MODE < 3 ? MODE + 1 : 3)>(lds, p, nb, nh); }
        __builtin_amdgcn_sched_barrier(0);
        v4i16 vlo[2][NKK], vhi[2][NKK];
#define ATT_VREAD(db_, buf_) do { const unsigned vaddr = (unsigned)(__UINTPTR_TYPE__)(Sb + voffb + ((((db_) * 2 + ((fr & 3) >> 1)) ^ v7) << 4)); \
            _Pragma("unroll") for (int kk = 0; kk < NKK; ++kk) { \
                asm volatile("ds_read_b64_tr_b16 %0, %1 offset:%2" : "=v"(vlo[buf_][kk]) : "v"(vaddr), "i"(kk * 4096)); \
                asm volatile("ds_read_b64_tr_b16 %0, %1 offset:%2" : "=v"(vhi[buf_][kk]) : "v"(vaddr), "i"(kk * 4096 + 2048)); } } while (0)
        ATT_VREAD(0, 0);
#pragma unroll
        for (int db = 0; db < 4; ++db) {
            if (db < 3) { ATT_VREAD(db + 1, (db + 1) & 1); asm volatile("s_waitcnt lgkmcnt(%0)" :: "i"(2 * NKK) : "memory"); }
            else asm volatile("s_waitcnt lgkmcnt(0)" ::: "memory");
            __builtin_amdgcn_sched_barrier(0);
#pragma unroll
            for (int kk = 0; kk < NKK; ++kk) {
                const bf16x8 vf = __builtin_shufflevector(vlo[db & 1][kk], vhi[db & 1][kk], 0, 1, 2, 3, 4, 5, 6, 7);
#pragma unroll
                for (int g = 0; g < QG; ++g) o[g][db] = __builtin_amdgcn_mfma_f32_16x16x32_bf16(vf, pf[g][kk], o[g][db], 0, 0, 0);
            }
            __builtin_amdgcn_sched_barrier(0);
        }
#undef ATT_VREAD
#pragma unroll
        for (int kk = 0; kk < NKK; ++kk)
#pragma unroll
            for (int g = 0; g < QG; ++g) ol[g] = __builtin_amdgcn_mfma_f32_16x16x32_bf16(vones, pf[g][kk], ol[g], 0, 0, 0);
    };
    for (int t = 0; t < ntile; t += 3) {
        step(t, SL0{}, SL2{});
        if (t + 1 < ntile) step(t + 1, SL1{}, SL0{});
        if (t + 2 < ntile) step(t + 2, SL2{}, SL1{});
    }
#undef ATT_GLDS
    asm volatile("s_waitcnt lgkmcnt(0)" ::: "memory");
    __builtin_amdgcn_s_barrier();
    bf16_t* O = (bf16_t*)(p.ws + OFF_MIXIN);
#pragma unroll
    for (int g = 0; g < QG; ++g) {
        float lt = rows_sum(fq == 0 ? ol[g][0] : 0.f);
        const float inv = 1.f / lt;
        const size_t row = (size_t)(qrow0 + g * 16 + fr);
#pragma unroll
        for (int d = 0; d < 4; d += 2) {
            const unsigned a0 = pk2(o[g][d][0] * inv, o[g][d][1] * inv), a1 = pk2(o[g][d][2] * inv, o[g][d][3] * inv);
            const unsigned b0 = pk2(o[g][d + 1][0] * inv, o[g][d + 1][1] * inv), b1 = pk2(o[g][d + 1][2] * inv, o[g][d + 1][3] * inv);
            const auto r0 = __builtin_amdgcn_permlane16_swap(a0, b0, false, false), r1 = __builtin_amdgcn_permlane16_swap(a1, b1, false, false);
            *(u32x4*)(O + row * 1024 + ocol + (d + (fq & 1)) * 16 + (fq & ~1) * 4) = (u32x4){r0[0], r1[0], r0[1], r1[1]};
        }
    }
}

DEVI void phase_s4(lchar* lds, const Params& p, int l) {
    const int G = gridDim.x, bid = blockIdx.x;
    const int ctotal = bid < NCHUNK ? (NCHUNK - bid + G - 1) / G : 0;
    ConvRide cr; cr.j = 0; cr.pend = -1; cr.nj = min(ctotal, CD_MAX);
    cride_table(lds, p, l, 0, cr.nj);
    const int nc3 = l == 0 ? 32 : 0;
    if (G == 256) {
        const int v = bid, b = v & 7, h = (v >> 3) & 3, qi = v >> 5;
        const int cm = (nc3 > 0 && bid < 4 * nc3) ? bid / nc3 : -1, cv = nc3 > 0 ? bid % nc3 : 0, cb = cv & 7, ch = (cv >> 3) & 3;
        bool pre = false;
#define ATT_RUN(M, CQ, B_, H_, QI_, HASNEXT, NXCODE, NB_, NH_, NEXTSLOT) do { const int nt_ = attn_ntile<M>(QI_, CQ); \
            const bool ok_ = (HASNEXT) && ((nt_ - 1) % 3) * attn_slot_bytes<M>() >= (NEXTSLOT); \
            attn_unit<M>(lds, p, l, B_, H_, QI_, CQ, cr, pre, ok_ ? (NXCODE) : 0, NB_, NH_); pre = ok_; } while (0)
        ATT_RUN(0, false, b, h, qi, true, cm == 0 ? 1 : 2, cm == 0 ? cb : b, cm == 0 ? ch : h, cm == 0 ? attn_slot_bytes<0>() : attn_slot_bytes<1>());
        if (cm == 0) ATT_RUN(0, true, cb, ch, 0, true, 2, b, h, attn_slot_bytes<1>());
        ATT_RUN(1, false, b, h, qi, true, cm == 1 ? 1 : 2, cm == 1 ? cb : b, cm == 1 ? ch : h, cm == 1 ? attn_slot_bytes<1>() : attn_slot_bytes<2>());
        if (cm == 1) ATT_RUN(1, true, cb, ch, 0, true, 2, b, h, attn_slot_bytes<2>());
        ATT_RUN(2, false, b, h, qi, true, cm == 2 ? 1 : 2, cm == 2 ? cb : b, cm == 2 ? ch : h, cm == 2 ? attn_slot_bytes<2>() : attn_slot_bytes<3>());
        if (cm == 2) ATT_RUN(2, true, cb, ch, 0, true, 2, b, h, attn_slot_bytes<3>());
        ATT_RUN(3, false, b, h, qi, cm == 3, 1, cb, ch, attn_slot_bytes<3>());
        if (cm == 3) ATT_RUN(3, true, cb, ch, 0, false, 0, -1, -1, 0);
#undef ATT_RUN
    } else {
    for (int u = bid; u < 256 + nc3; u += G) { const bool cq = u >= 256; const int v = cq ? u - 256 : u; attn_unit<0>(lds, p, l, v & 7, (v >> 3) & 3, v >> 5, cq, cr, false, 0); }
    for (int u = bid; u < 256 + nc3; u += G) { const bool cq = u >= 256; const int v = cq ? u - 256 : u; attn_unit<1>(lds, p, l, v & 7, (v >> 3) & 3, v >> 5, cq, cr, false, 0); }
    for (int u = bid; u < 256 + nc3; u += G) { const bool cq = u >= 256; const int v = cq ? u - 256 : u; attn_unit<2>(lds, p, l, v & 7, (v >> 3) & 3, v >> 5, cq, cr, false, 0); }
    for (int u = bid; u < 256 + nc3; u += G) { const bool cq = u >= 256; const int v = cq ? u - 256 : u; attn_unit<3>(lds, p, l, v & 7, (v >> 3) & 3, v >> 5, cq, cr, false, 0); }
    }
    asm volatile("s_waitcnt vmcnt(0) lgkmcnt(0)" ::: "memory");
    __builtin_amdgcn_s_barrier();
    if (cr.pend >= 0) cride_consume(lds, cr.pend, cride_boff(cr.pend));
    for (int base = 0;;) {
        while (cr.j < cr.nj) {
            const int n = min(cr.nj - cr.j, 6);
            for (int i = 0; i < n; ++i) cride_issue(lds, cr.j + i, i * CB_BUF);
            asm volatile("s_waitcnt vmcnt(0) lgkmcnt(0)" ::: "memory");
            __builtin_amdgcn_s_barrier();
            for (int i = 0; i < n; ++i) cride_consume(lds, cr.j + i, i * CB_BUF);
            cr.j += n;
            asm volatile("s_waitcnt lgkmcnt(0)" ::: "memory");
            __builtin_amdgcn_s_barrier();
        }
        base += CD_MAX; if (base >= ctotal) break;
        cr.j = 0; cr.nj = min(ctotal - base, CD_MAX);
        cride_table(lds, p, l, base, cr.nj);
    }
    asm volatile("s_waitcnt vmcnt(0) lgkmcnt(0)" ::: "memory");
    __syncthreads();
}

DEVI void phase_s6(lchar* lds, const Params& p, int l) {
    constexpr int RS = 2064, LO_OFF = 16 * RS;
    const int tid = ltid(), wid = tid >> 6, lane = tid & 63, fr = lane & 15, fq = lane >> 4, G = gridDim.x;
    const int ntile = (l == 0 ? T_ALL : T_LAT) / RT_TILE;
    LAS float* lg = (LAS float*)lds;
    LAS int* tot = (LAS int*)(lds + 8192);
    const bf16_t* MIX = (const bf16_t*)(p.ws + OFF_MIX); const bf16_t* MIXC = (const bf16_t*)(p.ws + OFF_MIXC);
    bf16_t* H = (bf16_t*)(p.ws + OFF_H);
    const float* pg = p.post_mix_g + l * 1024; const float* fg = p.pre_ffn_g + l * 1024;
    unsigned char* e8 = (unsigned char*)(p.ws + OFF_E8); float* w8 = (float*)(p.ws + OFF_W8); unsigned short* lr8 = (unsigned short*)(p.ws + OFF_LR8);
    unsigned char* hist = (unsigned char*)(p.ws + OFF_HIST);
    const float rbias = p.router_b[l * 64 + lane];
    const u32x4* wt = (const u32x4*)(p.ws + OFF_WRT) + ((size_t)((l * 4 + (wid & 3)) * 32 + (wid >> 2) * 16) * 2) * 64 + lane;
#define RT_LOADB(dst, b) do { const u32x4* wb_ = wt + (b) * 8 * 64; asm volatile("" : "+v"(wb_)); _Pragma("unroll") for (int i = 0; i < 8; ++i) dst[i] = wb_[i * 64]; } while (0)
    u32x2 mu[2][4]; float4 xv[2][4];
    bf16_t* XB = (bf16_t*)(p.ws + OFF_XB);
#define S6_LOAD(TILE) do { _Pragma("unroll") for (int r2 = 0; r2 < 2; ++r2) { const int r_ = (TILE) * RT_TILE + wid * 2 + r2; const float* xr = xrow_ptr(p, 0, r_); \
        _Pragma("unroll") for (int i = 0; i < 4; ++i) { mu[r2][i] = __builtin_nontemporal_load((const u32x2*)((r_ < T_LAT ? MIX + (size_t)r_ * 1024 : MIXC + (size_t)(r_ - T_LAT) * 1024) + i * 256 + lane * 4)); \
            if (l == 0) { const f32x4 x4_ = __builtin_nontemporal_load((const f32x4*)(xr + i * 256 + lane * 4)); xv[r2][i] = make_float4(x4_[0], x4_[1], x4_[2], x4_[3]); } \
            else { const u32x2 t_ = __builtin_nontemporal_load((const u32x2*)(XB + (size_t)r_ * 1024 + i * 256 + lane * 4)); xv[r2][i].x = __uint_as_float(t_[0]); xv[r2][i].y = __uint_as_float(t_[1]); } } } } while (0)
    if ((int)blockIdx.x < ntile) S6_LOAD(blockIdx.x);
    for (int tile = blockIdx.x; tile < ntile; tile += G) {
        {
            const int r0 = tile * RT_TILE + wid * 2;
            const int bb = r0 < T_LAT ? (r0 >> 11) : 8;
            const float* mod = (const float*)(p.ws + OFF_MOD) + ((size_t)l * 9 + bb) * 6144;
            float4 gg[4], g1[4], fgv[4], sh[4], sc[4];
#pragma unroll
            for (int i = 0; i < 4; ++i) { const int c = i * 256 + lane * 4;
                gg[i] = *(const float4*)(pg + c); g1[i] = *(const float4*)(mod + 2048 + c); fgv[i] = *(const float4*)(fg + c);
                sh[i] = *(const float4*)(mod + 3072 + c); sc[i] = *(const float4*)(mod + 4096 + c); }
#pragma unroll
            for (int r2 = 0; r2 < 2; ++r2) {
                const int r = r0 + r2;
                float mv[16]; float ss = 0.f;
#pragma unroll
                for (int i = 0; i < 4; ++i) { mv[i * 4 + 0] = bflo(mu[r2][i][0]); mv[i * 4 + 1] = bfhi(mu[r2][i][0]); mv[i * 4 + 2] = bflo(mu[r2][i][1]); mv[i * 4 + 3] = bfhi(mu[r2][i][1]); }
                if (r >= T_LAT) {
#pragma unroll
                    for (int kq = 1; kq < 4; ++kq)
#pragma unroll
                        for (int i = 0; i < 4; ++i) { const u32x2 pm = *(const u32x2*)(MIXC + ((size_t)kq * T_CTX + (r - T_LAT)) * 1024 + i * 256 + lane * 4);
                            mv[i * 4 + 0] += bflo(pm[0]); mv[i * 4 + 1] += bfhi(pm[0]); mv[i * 4 + 2] += bflo(pm[1]); mv[i * 4 + 3] += bfhi(pm[1]); }
                }
#pragma unroll
                for (int i = 0; i < 16; ++i) ss += mv[i] * mv[i];
                ss = wave_sum(ss);
                const float rs1 = rsqrtf(ss * (1.f / 1024.f) + EPS);
                float x1[16]; float s2 = 0.f;
#pragma unroll
                for (int i = 0; i < 4; ++i) {
                    float4 xx = xv[r2][i];
                    if (l != 0) { const unsigned u0 = __float_as_uint(xx.x), u1 = __float_as_uint(xx.y); xx = make_float4(bflo(u0), bfhi(u0), bflo(u1), bfhi(u1)); }
                    x1[i * 4 + 0] = xx.x + g1[i].x * (mv[i * 4 + 0] * rs1 * gg[i].x); x1[i * 4 + 1] = xx.y + g1[i].y * (mv[i * 4 + 1] * rs1 * gg[i].y);
                    x1[i * 4 + 2] = xx.z + g1[i].z * (mv[i * 4 + 2] * rs1 * gg[i].z); x1[i * 4 + 3] = xx.w + g1[i].w * (mv[i * 4 + 3] * rs1 * gg[i].w);
                    *(u32x2*)(XB + (size_t)r * 1024 + i * 256 + lane * 4) = (u32x2){pk2(x1[i * 4 + 0], x1[i * 4 + 1]), pk2(x1[i * 4 + 2], x1[i * 4 + 3])};
                }
#pragma unroll
                for (int i = 0; i < 16; ++i) s2 += x1[i] * x1[i];
                s2 = wave_sum(s2);
                const float rs2 = rsqrtf(s2 * (1.f / 1024.f) + EPS);
#pragma unroll
                for (int i = 0; i < 4; ++i) {
                    const int c = i * 256 + lane * 4;
                    const float a0 = x1[i * 4 + 0] * rs2 * fgv[i].x * (1.f + sc[i].x) + sh[i].x, a1 = x1[i * 4 + 1] * rs2 * fgv[i].y * (1.f + sc[i].y) + sh[i].y;
                    const float a2 = x1[i * 4 + 2] * rs2 * fgv[i].z * (1.f + sc[i].z) + sh[i].z, a3 = x1[i * 4 + 3] * rs2 * fgv[i].w * (1.f + sc[i].w) + sh[i].w;
                    const unsigned h0 = pk2(a0, a1), h1 = pk2(a2, a3);
                    {
                        const float q0 = fminf(fmaxf(a0 * H2_SCALE, -448.f), 448.f), q1 = fminf(fmaxf(a1 * H2_SCALE, -448.f), 448.f), q2 = fminf(fmaxf(a2 * H2_SCALE, -448.f), 448.f), q3 = fminf(fmaxf(a3 * H2_SCALE, -448.f), 448.f);
                        int w8_ = __builtin_amdgcn_cvt_pk_fp8_f32(q0, q1, 0, false); w8_ = __builtin_amdgcn_cvt_pk_fp8_f32(q2, q3, w8_, true);
                        *(unsigned*)((unsigned char*)H + (size_t)r * 1024 + c) = (unsigned)w8_;
                    }
                    *(LAS u32x2*)(lds + (wid * 2 + r2) * RS + c * 2) = (u32x2){h0, h1};
                    *(LAS u32x2*)(lds + LO_OFF + (wid * 2 + r2) * RS + c * 2) = (u32x2){pk2(a0 - bflo(h0), a1 - bfhi(h0)), pk2(a2 - bflo(h1), a3 - bfhi(h1))};
                }
            }
        }
        u32x4 bA[8], bB[8];
        __builtin_amdgcn_sched_barrier(0);
        RT_LOADB(bA, 0); RT_LOADB(bB, 1);
        __builtin_amdgcn_sched_barrier(0);
        __syncthreads();
        f32x4 acc0 = {0.f, 0.f, 0.f, 0.f}, acc1 = {0.f, 0.f, 0.f, 0.f}, acc2 = {0.f, 0.f, 0.f, 0.f};
        const lchar* ha = lds + fr * RS + ((wid >> 2) * 512 + fq * 8) * 2;
#define RT_MMA(src, b) do { _Pragma("unroll") for (int i = 0; i < 4; ++i) { const bf16x8 ah = *(const LAS bf16x8*)(ha + ((b) * 4 + i) * 64), al = *(const LAS bf16x8*)(ha + LO_OFF + ((b) * 4 + i) * 64); \
            const bf16x8 wh = __builtin_bit_cast(bf16x8, src[2 * i]), wl = __builtin_bit_cast(bf16x8, src[2 * i + 1]); \
            acc0 = __builtin_amdgcn_mfma_f32_16x16x32_bf16(ah, wh, acc0, 0, 0, 0); acc1 = __builtin_amdgcn_mfma_f32_16x16x32_bf16(ah, wl, acc1, 0, 0, 0); \
            acc2 = __builtin_amdgcn_mfma_f32_16x16x32_bf16(al, wh, acc2, 0, 0, 0); } } while (0)
        RT_MMA(bA, 0); __builtin_amdgcn_sched_barrier(0);
        RT_LOADB(bA, 2); __builtin_amdgcn_sched_barrier(0);
        RT_MMA(bB, 1); __builtin_amdgcn_sched_barrier(0);
        RT_LOADB(bB, 3);
        if (tile + G < ntile) S6_LOAD(tile + G);
        __builtin_amdgcn_sched_barrier(0);
        RT_MMA(bA, 2);
        RT_MMA(bB, 3);
        __syncthreads();
#pragma unroll
        for (int j = 0; j < 4; ++j) lg[((wid >> 2) * 16 + fq * 4 + j) * 64 + (wid & 3) * 16 + fr] = acc0[j] + (acc1[j] + acc2[j]);
        __syncthreads();
        int cntw = 0; bool sel[2]; int jj[2], lrw[2]; float ww[2];
#pragma unroll
        for (int t = 0; t < 2; ++t) {
            const float lgt = lg[(wid * 2 + t) * 64 + lane] + lg[(16 + wid * 2 + t) * 64 + lane];
            const float sg = __frcp_rn(1.f + __expf(-lgt)), sb = sg + rbias;
            const float m1 = gmax8(sb);
            const unsigned long long eqm = __ballot(sb == m1);
            const int gbase = lane & ~7;
            const unsigned gm = (unsigned)(eqm >> gbase) & 0xffu;
            const int am = gbase + __ffs(gm) - 1;
            const float m2 = gmax8(lane == am ? -INFINITY : sb);
            const float gs = m1 + m2;
            const int myg = lane >> 3; int grank = 0;
#pragma unroll
            for (int g2 = 0; g2 < 8; ++g2) { const float ov = __int_as_float(__builtin_amdgcn_readlane(__float_as_int(gs), g2 * 8)); grank += (ov > gs || (ov == gs && g2 < myg)) ? 1 : 0; }
            const bool gsel = grank < 4;
            const float v = gsel ? sb : -INFINITY;
            float vv = v; bool picked = false;
#pragma unroll
            for (int r8 = 0; r8 < 8; ++r8) {
                const float mx = wave_max_dpp(vv);
                const unsigned long long eq = __ballot(vv == mx);
                const int first = (int)__ffsll((long long)eq) - 1;
                if (lane == first) { picked = true; vv = -INFINITY; }
            }
            sel[t] = picked;
            const float wsum = wave_sum_dpp(sel[t] ? sg : 0.f);
            const unsigned long long sm = __ballot(sel[t]);
            jj[t] = __popcll(sm & ((1ull << lane) - 1ull));
            ww[t] = sg / wsum * 2.5f;
            lrw[t] = cntw; cntw += sel[t] ? 1 : 0;
        }
        tot[wid * 64 + lane] = cntw;
        __syncthreads();
        int base = 0, total = 0;
#pragma unroll
        for (int w = 0; w < NW; ++w) { const int c = tot[w * 64 + lane]; base += w < wid ? c : 0; total += c; }
        if (wid == 0) hist[tile * 64 + lane] = (unsigned char)total;
#pragma unroll
        for (int t = 0; t < 2; ++t) if (sel[t]) {
            const size_t idx = (size_t)(tile * RT_TILE + wid * 2 + t) * 8 + jj[t];
            e8[idx] = (unsigned char)lane; w8[idx] = ww[t]; lr8[idx] = (unsigned short)(base + lrw[t]);
        }
        __syncthreads();
    }
#undef S6_LOAD
#undef RT_LOADB
#undef RT_MMA
}

DEVI void phase_s7(const Params& p, int l) {
    const int wid = ltid() >> 6, lane = ltid() & 63, gw = blockIdx.x * NW + wid;
    if (gw >= 64) return;
    constexpr int PER = (MAX_RT + 63) / 64;
    const int ntile = (l == 0 ? T_ALL : T_LAT) / RT_TILE, e = gw;
    const unsigned char* hist = (const unsigned char*)(p.ws + OFF_HIST); int* toff = (int*)(p.ws + OFF_TOFF); int* cnt = (int*)(p.ws + OFF_CNT);
    int h[PER]; int sum = 0;
#pragma unroll
    for (int i = 0; i < PER; ++i) { const int tt = lane * PER + i; h[i] = tt < ntile ? hist[tt * 64 + e] : 0; }
#pragma unroll
    for (int i = 0; i < PER; ++i) sum += h[i];
    int inc = 0;
#pragma unroll
    for (int j = 0; j < 64; ++j) { const int sj = __builtin_amdgcn_readlane(sum, j); if (lane >= j) inc += sj; }
    int run = inc - sum;
#pragma unroll
    for (int i = 0; i < PER; ++i) { const int tt = lane * PER + i; if (tt < ntile) toff[tt * 64 + e] = run; run += h[i]; }
    if (lane == 63) cnt[e] = inc;
}

DEVI void phase_s8(lchar* lds, const Params& p, int l) {
    build_seg(lds, p);
    LAS int* seg = (LAS int*)(lds + SEG_OFF);
    const int ntok = l == 0 ? T_ALL : T_LAT, n = ntok * 8;
    const unsigned char* e8 = (const unsigned char*)(p.ws + OFF_E8); const unsigned short* lr8 = (const unsigned short*)(p.ws + OFF_LR8);
    const int* toff = (const int*)(p.ws + OFF_TOFF); const int* cnt = (const int*)(p.ws + OFF_CNT);
    int* stk = (int*)(p.ws + OFF_STK); int* tsl = (int*)(p.ws + OFF_TSL);
    const int step8 = gridDim.x * NT;
    for (int i0 = blockIdx.x * NT + ltid(); i0 < n; i0 += 2 * step8) {
        const int i1 = i0 + step8; const bool two = i1 < n;
        const int e0 = e8[i0], r0 = lr8[i0], e1 = two ? e8[i1] : 0, r1 = two ? lr8[i1] : 0;
        const int o0 = toff[((i0 >> 3) / RT_TILE) * 64 + e0], o1 = two ? toff[((i1 >> 3) / RT_TILE) * 64 + e1] : 0;
        const int s0 = seg[e0] + o0 + r0, s1 = seg[e1] + o1 + r1;
        stk[s0] = i0 >> 3; tsl[i0] = s0;
        if (two) { stk[s1] = i1 >> 3; tsl[i1] = s1; }
    }
    for (int e = blockIdx.x; e < 64; e += gridDim.x) { const int s0 = seg[e] + cnt[e], s1 = seg[e + 1]; for (int s = s0 + ltid(); s < s1; s += NT) stk[s] = 0; }
}

typedef int i32x4v __attribute__((ext_vector_type(4)));
DEVI void phase_s8f(lchar* lds, const Params& p, int l) {
    const int tid = ltid(), G = gridDim.x, bid = blockIdx.x;
    const int ntok = l == 0 ? T_ALL : T_LAT, n = ntok * 8, ntile = ntok / RT_TILE;
    const unsigned char* hist = (const unsigned char*)(p.ws + OFF_HIST);
    LAS int* red = (LAS int*)lds;
    LAS int* TOT = (LAS int*)(lds + 32768);
    LAS int* TL = (LAS int*)(lds + 34816);
    LAS int* seg = (LAS int*)(lds + SEG_OFF);
    const int tile0a = bid * 4, tile0b = (bid + G) * 4;
    const unsigned char* e8 = (const unsigned char*)(p.ws + OFF_E8); const unsigned short* lr8 = (const unsigned short*)(p.ws + OFF_LR8);
    const int i0 = bid * NT + tid, i1 = i0 + G * NT; const bool two = i1 < n;
    const int e0 = e8[i0], r0 = lr8[i0], e1 = two ? e8[i1] : 0, r1 = two ? lr8[i1] : 0;
    int hv[4];
    { const int t0 = (tid >> 7) ? tile0b : tile0a;
#pragma unroll
      for (int q = 0; q < 4; ++q) hv[q] = hist[min(t0 + q, ntile - 1) * 64 + (tid & 63)]; }
    {
        const int e4 = tid & 15, part = tid >> 4, per = (ntile + 31) >> 5;
        i32x4v tot = {0, 0, 0, 0}, pa = {0, 0, 0, 0}, pb = {0, 0, 0, 0};
        const unsigned* hist32 = (const unsigned*)hist;
        for (int j0 = 0; j0 < per; j0 += 18) {
            unsigned v[18];
#pragma unroll
            for (int j = 0; j < 18; ++j) { const int tt = min(part * per + j0 + j, ntile - 1); v[j] = hist32[tt * 16 + e4]; }
#pragma unroll
            for (int j = 0; j < 18; ++j) { const int tt = part * per + j0 + j; const bool ok = j0 + j < per && tt < ntile;
                const unsigned u = ok ? v[j] : 0u;
                const i32x4v z = {0, 0, 0, 0}, w = {(int)(u & 255u), (int)((u >> 8) & 255u), (int)((u >> 16) & 255u), (int)(u >> 24)};
                tot += w; pa += tt < tile0a ? w : z; pb += tt < tile0b ? w : z; }
        }
        *(LAS i32x4v*)(red + (0 * 32 + part) * 64 + e4 * 4) = tot; *(LAS i32x4v*)(red + (1 * 32 + part) * 64 + e4 * 4) = pa; *(LAS i32x4v*)(red + (2 * 32 + part) * 64 + e4 * 4) = pb;
    }
    __syncthreads();
    if (tid < 192) { const int which = tid >> 6, e = tid & 63; int sum = 0;
#pragma unroll
        for (int pp = 0; pp < 32; ++pp) sum += red[(which * 32 + pp) * 64 + e];
        TOT[which * 64 + e] = sum; }
    __syncthreads();
    if (tid < 64) {
        const int pc = (TOT[tid] + 255) & ~255; int inc = 0;
#pragma unroll
        for (int j = 0; j < 64; ++j) { const int sj = __builtin_amdgcn_readlane(pc, j); if (tid >= j) inc += sj; }
        seg[tid] = inc - pc; if (tid == 63) seg[64] = inc;
        if (bid == 0) ((int*)(p.ws + OFF_CNT))[tid] = TOT[tid];
    } else if (tid < 192) {
        const int k = (tid >> 6) - 1, e = tid & 63;
        int run = TOT[(1 + k) * 64 + e];
#pragma unroll
        for (int q = 0; q < 4; ++q) { TL[(k * 4 + q) * 64 + e] = run; run += hv[q]; }
    }
    __syncthreads();
    int* stk = (int*)(p.ws + OFF_STK); int* tsl = (int*)(p.ws + OFF_TSL);
    {
        const int q = tid >> 7;
        const int s0 = seg[e0] + TL[(0 * 4 + q) * 64 + e0] + r0, s1 = seg[e1] + TL[(1 * 4 + q) * 64 + e1] + r1;
        stk[s0] = i0 >> 3; tsl[i0] = s0;
        if (two) { stk[s1] = i1 >> 3; tsl[i1] = s1; }
    }
    for (int e = bid; e < 64; e += G) { const int s0 = seg[e] + TOT[e], s1 = seg[e + 1]; for (int sidx = s0 + tid; sidx < s1; sidx += NT) stk[sidx] = 0; }
}

DEVI void phase_s11(const Params& p, int l, bool do_store = true) {
    static_assert(Y8_ALL, "the combine reads fp8 rows");
    const int wid = ltid() >> 6, lane = ltid() & 63, gw = blockIdx.x * NW + wid, nw = gridDim.x * NW;
    const int ntok = l == 0 ? T_ALL : T_LAT;
    const int* tsl = (const int*)(p.ws + OFF_TSL); const float* w8 = (const float*)(p.ws + OFF_W8);
    const unsigned char* Y8 = (const unsigned char*)(p.ws + OFF_Y); const bf16_t* YS = (const bf16_t*)(p.ws + OFF_H);
    bf16_t* XBp = (bf16_t*)(p.ws + OFF_XB);
    const float* pg = p.post_ffn_g + l * 1024;
    float4 pgv[2][2];
#pragma unroll
    for (int i = 0; i < 2; ++i)
#pragma unroll
        for (int hq = 0; hq < 2; ++hq) pgv[i][hq] = *(const float4*)(pg + (lane + 64 * i) * 8 + hq * 4);
    float4 gnv[2][2];
    { const float* gn0 = p.pre_mix_g + min(l + 1, DEPTH - 1) * 1024;
#pragma unroll
      for (int i = 0; i < 2; ++i) { gnv[i][0] = *(const float4*)(gn0 + (lane + 64 * i) * 8); gnv[i][1] = *(const float4*)(gn0 + (lane + 64 * i) * 8 + 4); } }
    int slotN[2]; float wvN[2];
#define S11_SLOTS(T0) do { const int ta_ = (T0), tb_ = ta_ + nw; slotN[0] = 0; wvN[0] = 0.f; slotN[1] = 0; wvN[1] = 0.f; \
        if (ta_ < ntok) { slotN[0] = tsl[(size_t)ta_ * 8 + (lane & 7)]; wvN[0] = w8[(size_t)ta_ * 8 + (lane & 7)]; } \
        if (tb_ < ntok) { slotN[1] = tsl[(size_t)tb_ * 8 + (lane & 7)]; wvN[1] = w8[(size_t)tb_ * 8 + (lane & 7)]; } } while (0)
    S11_SLOTS(gw);
    for (int t0 = gw; t0 < ntok; t0 += 2 * nw) {
        const int t1 = t0 + nw; const bool two = t1 < ntok;
        int slot[2]; float wv[2];
        slot[0] = slotN[0]; slot[1] = slotN[1]; wv[0] = wvN[0]; wv[1] = wvN[1];
        S11_SLOTS(t0 + 2 * nw);
        u32x2 yv[2][8][2]; u32x4 ys[2][2], xr[2][2];
#pragma unroll
        for (int u = 0; u < 2; ++u) if (u == 0 || two) {
            const int t = u ? t1 : t0;
#pragma unroll
            for (int j = 0; j < 8; ++j) { const unsigned char* row8 = Y8 + (size_t)__builtin_amdgcn_readlane(slot[u], j) * 1024;
#pragma unroll
                for (int i = 0; i < 2; ++i) yv[u][j][i] = __builtin_nontemporal_load((const u32x2*)(row8 + (lane + 64 * i) * 8)); }
#pragma unroll
            for (int i = 0; i < 2; ++i) { ys[u][i] = __builtin_nontemporal_load((const u32x4*)(YS + (size_t)t * 1024 + (lane + 64 * i) * 8)); xr[u][i] = __builtin_nontemporal_load((const u32x4*)(XBp + (size_t)t * 1024 + (lane + 64 * i) * 8)); }
        }
        __builtin_amdgcn_sched_barrier(0);
#pragma unroll
        for (int u = 0; u < 2; ++u) if (u == 0 || two) {
            const int t = u ? t1 : t0;
            float f[16];
#pragma unroll
            for (int i = 0; i < 16; ++i) f[i] = 0.f;
#pragma unroll
            for (int j = 0; j < 8; ++j) {
                const float wq = __int_as_float(__builtin_amdgcn_readlane(__float_as_int(wv[u]), j)) * (1.f / 64.f);
#pragma unroll
                for (int i = 0; i < 2; ++i)
#pragma unroll
                    for (int q = 0; q < 2; ++q) { const f32x2 lo = __builtin_amdgcn_cvt_pk_f32_fp8((int)yv[u][j][i][q], false), hi = __builtin_amdgcn_cvt_pk_f32_fp8((int)yv[u][j][i][q], true);
                        f[i * 8 + 4 * q + 0] += wq * lo[0]; f[i * 8 + 4 * q + 1] += wq * lo[1]; f[i * 8 + 4 * q + 2] += wq * hi[0]; f[i * 8 + 4 * q + 3] += wq * hi[1]; }
            }
#pragma unroll
            for (int i = 0; i < 2; ++i)
#pragma unroll
                for (int q = 0; q < 4; ++q) { f[i * 8 + 2 * q] += bflo(ys[u][i][q]); f[i * 8 + 2 * q + 1] += bfhi(ys[u][i][q]); }
            float ss = 0.f;
#pragma unroll
            for (int i = 0; i < 16; ++i) ss += f[i] * f[i];
            ss = wave_sum(ss);
            const float rs = rsqrtf(ss * (1.f / 1024.f) + EPS);
            const int bb = t < T_LAT ? (t >> 11) : 8;
            const float* g2 = (const float*)(p.ws + OFF_MOD) + ((size_t)l * 9 + bb) * 6144 + 5120;
            bf16_t* xb = XBp + (size_t)t * 1024;
#pragma unroll
            for (int i = 0; i < 2; ++i) {
#pragma unroll
                for (int hq = 0; hq < 2; ++hq) {
                    const int c = (lane + 64 * i) * 8 + hq * 4;
                    const float4 xv = make_float4(bflo(xr[u][i][hq * 2]), bfhi(xr[u][i][hq * 2]), bflo(xr[u][i][hq * 2 + 1]), bfhi(xr[u][i][hq * 2 + 1])), gg = pgv[i][hq], gv = *(const float4*)(g2 + c);
                    float4 r;
                    r.x = xv.x + gv.x * (f[i * 8 + hq * 4 + 0] * rs * gg.x); r.y = xv.y + gv.y * (f[i * 8 + hq * 4 + 1] * rs * gg.y);
                    r.z = xv.z + gv.z * (f[i * 8 + hq * 4 + 2] * rs * gg.z); r.w = xv.w + gv.w * (f[i * 8 + hq * 4 + 3] * rs * gg.w);
                    if (l + 1 == DEPTH) { if (do_store) *(float4*)(p.out + (size_t)t * 1024 + c) = r; else asm volatile("" :: "v"(r.x), "v"(r.y), "v"(r.z), "v"(r.w)); }
                    f[i * 8 + hq * 4 + 0] = r.x; f[i * 8 + hq * 4 + 1] = r.y; f[i * 8 + hq * 4 + 2] = r.z; f[i * 8 + hq * 4 + 3] = r.w;
                }
                if (l + 1 < DEPTH) {
                    const u32x4 w = {pk2(f[i * 8 + 0], f[i * 8 + 1]), pk2(f[i * 8 + 2], f[i * 8 + 3]), pk2(f[i * 8 + 4], f[i * 8 + 5]), pk2(f[i * 8 + 6], f[i * 8 + 7])};
                    if (do_store) *(u32x4*)(xb + (lane + 64 * i) * 8) = w; else asm volatile("" :: "v"(w[0]), "v"(w[1]), "v"(w[2]), "v"(w[3]));
                }
            }
            if (l + 1 < DEPTH) {
                float s2 = 0.f;
#pragma unroll
                for (int i = 0; i < 16; ++i) s2 += f[i] * f[i];
                s2 = wave_sum(s2);
                const float rs2 = rsqrtf(s2 * (1.f / 1024.f) + EPS);
                const float* md = (const float*)(p.ws + OFF_MOD) + ((size_t)(l + 1) * 9 + bb) * 6144;
                const float* gn = p.pre_mix_g + (l + 1) * 1024;
                bf16_t* H = (bf16_t*)(p.ws + OFF_H);
#pragma unroll
                for (int i = 0; i < 2; ++i) {
                    const int c = (lane + 64 * i) * 8;
                    const float4 ga = gnv[i][0], gb = gnv[i][1], sha = *(const float4*)(md + c), shb = *(const float4*)(md + c + 4);
                    const float4 sca = *(const float4*)(md + 1024 + c), scb = *(const float4*)(md + 1024 + c + 4);
                    const float a0 = f[i * 8 + 0] * rs2 * ga.x * (1.f + sca.x) + sha.x, a1 = f[i * 8 + 1] * rs2 * ga.y * (1.f + sca.y) + sha.y;
                    const float a2 = f[i * 8 + 2] * rs2 * ga.z * (1.f + sca.z) + sha.z, a3 = f[i * 8 + 3] * rs2 * ga.w * (1.f + sca.w) + sha.w;
                    const float a4 = f[i * 8 + 4] * rs2 * gb.x * (1.f + scb.x) + shb.x, a5 = f[i * 8 + 5] * rs2 * gb.y * (1.f + scb.y) + shb.y;
                    const float a6 = f[i * 8 + 6] * rs2 * gb.z * (1.f + scb.z) + shb.z, a7 = f[i * 8 + 7] * rs2 * gb.w * (1.f + scb.w) + shb.w;
                    if (do_store) *(u32x4*)(H + (size_t)t * 1024 + c) = (u32x4){pk2(a0, a1), pk2(a2, a3), pk2(a4, a5), pk2(a6, a7)};
                }
            }
        }
    }
}

constexpr int N_PHASES = 1 + 2 * 11;
__global__ void __launch_bounds__(NT, 2) mega(Params p) {
    extern __shared__ __attribute__((aligned(16))) char smem[];
    lchar* lds = (lchar*)smem;
    const int G = gridDim.x, bid = blockIdx.x;
    const bool multi = p.ph_hi - p.ph_lo > 1;
    XcdBarrier bar;
    if (multi) {
        volatile LAS unsigned* xbw = (volatile LAS unsigned*)(lds + LDS_XB);
        if (threadIdx.x == 0) { xbw[0] = 0u; xbw[1] = 0u; xbw[2] = 0u; xbw[3] = 0u; }
        __syncthreads();
        bar = xcd_barrier_post((unsigned*)(p.ws + OFF_CTL), xbw);
    }
#ifndef AUDIT_MASK
#define AUDIT_MASK 0xfff
#endif
#define EN(j) (((AUDIT_MASK) >> (j)) & 1)
#ifndef REPEAT_MASK
#define REPEAT_MASK 0
#endif
#define NREP(j) ((((REPEAT_MASK) >> (j)) & 1) ? 2 : 1)
#define PH(k) (p.ph_lo <= (k) && (k) < p.ph_hi)
#define SEG_KEPT (gridDim.x == 256 && EN(8) && PH(pb + 7) && NREP(9) == 1 && NREP(10) == 1)
#ifdef PROBE_A
#define STAMP(i) do { if (bid == 0 && threadIdx.x == 0) ((unsigned long long*)(p.ws + OFF_CTL + 32768))[i] = __builtin_amdgcn_s_memrealtime(); } while (0)
#else
#define STAMP(i) do { } while (0)
#endif
#define SEAM(k) do { if (p.ph_lo <= (k) && (k) + 1 < p.ph_hi) { XcdBarrier bb_ = bar; asm volatile("" : "+s"(bb_.bar)); xcd_barrier(bb_); } STAMP((k) + 1); } while (0)
    STAMP(0);
    if (EN(0) && PH(0)) for (int rep = 0; rep < NREP(0); ++rep) { const Params q = ldp(); phase_s0(lds, q); }
#ifdef EXTRA_BARRIERS
    if (multi) for (int xb = 0; xb < EXTRA_BARRIERS; ++xb) { XcdBarrier bb_ = bar; asm volatile("" : "+s"(bb_.bar)); xcd_barrier(bb_); }
#endif
    SEAM(0);
    for (int l = 0; l < 2; ++l) {
        const int pb = 1 + l * 11;
        const int nmt_all = l == 0 ? T_ALL / 128 : T_LAT / 128;
        if (EN(1) && PH(pb + 0)) for (int rep = 0; rep < NREP(1); ++rep) { const Params q = ldp(); if (l == 0) phase_s1(q, l); }
        if (l == 0) SEAM(pb + 0);
        if (EN(2) && PH(pb + 1)) for (int rep = 0; rep < NREP(2); ++rep) { const Params q = ldp(); Inproj8 S{q, l, lds}; gemm8_phase(lds, S); }
        SEAM(pb + 1);
        if (EN(3) && PH(pb + 2)) for (int rep = 0; rep < NREP(3); ++rep) { const Params q = ldp(); Kvup8 S{q, l}; gemm8_phase(lds, S); }
        SEAM(pb + 2);
        if (EN(4) && PH(pb + 3)) for (int rep = 0; rep < NREP(4); ++rep) { const Params q = ldp(); phase_s4(lds, q, l); }
        SEAM(pb + 3);
        if (EN(5) && PH(pb + 4)) for (int rep = 0; rep < NREP(5); ++rep) { const Params q = ldp(); Outproj8 S{q, l, T_LAT / 256}; gemm8_phase(lds, S); if (l == 0) { OutprojCtx8 S2{q, l}; gemm8_phase(lds, S2); } }
        SEAM(pb + 4);
        if (EN(6) && PH(pb + 5)) for (int rep = 0; rep < ((l == 0 && 5 != 10) ? NREP(6) : 1); ++rep) { const Params q = ldp(); phase_s6(lds, q, l); }
        SEAM(pb + 5);
        if (EN(7) && PH(pb + 6)) for (int rep = 0; rep < NREP(7); ++rep) { const Params q = ldp(); if (gridDim.x != 256) phase_s7(q, l); }
        if (gridDim.x != 256) SEAM(pb + 6);
        if (EN(8) && PH(pb + 7)) for (int rep = 0; rep < NREP(8); ++rep) { const Params q = ldp(); if (gridDim.x == 256) phase_s8f(lds, q, l); else phase_s8(lds, q, l); }
        SEAM(pb + 7);
        if (EN(9) && PH(pb + 8)) for (int rep = 0; rep < NREP(9); ++rep) { const Params q = ldp(); if (!(SEG_KEPT)) build_seg(lds, q); const int nmt_r = __builtin_amdgcn_readfirstlane(((LAS int*)(lds + SEG_OFF))[64]) >> 8; Gateup8 S{q, lds, nmt_r, nmt_all / 2}; build_goff(q, nmt_r, S); gemm8_phase(lds, S); }
        SEAM(pb + 8);
        if (EN(10) && PH(pb + 9)) for (int rep = 0; rep < NREP(10); ++rep) { const Params q = ldp(); if (!(SEG_KEPT)) build_seg(lds, q); const int nmt_r = __builtin_amdgcn_readfirstlane(((LAS int*)(lds + SEG_OFF))[64]) >> 8; Down8 S{q, lds, nmt_r, nmt_all / 2, Y8_ALL || l == DEPTH - 1}; gemm8_phase(lds, S); }
        SEAM(pb + 9);
        if (EN(11) && PH(pb + 10)) { const Params q = ldp(); if (NREP(11) == 2) phase_s11(q, l, p.ph_lo == 777); phase_s11(q, l); }
        SEAM(pb + 10);
    }
#ifdef PROBE_A
    __syncthreads();
    if (bid == 0 && threadIdx.x == 0) {
        const unsigned long long* ts = (const unsigned long long*)(p.ws + OFF_CTL + 32768);
        p.out[0] = 1000.f * (float)(ts[PROBE_B] - ts[PROBE_A]) * 0.01f;
    }
#endif
}

extern "C" void kernel_launch(void* const* d_in, const int* in_sizes, int n_in, void* d_out, int out_size, void* d_ws, size_t ws_size, hipStream_t stream) {
    if (n_in < 26 || ws_size < WS_NEED) { fprintf(stderr, "kernel_launch: bad arguments (n_in %d, ws %zu < %zu)\n", n_in, ws_size, (size_t)WS_NEED); return; }
    Params p{};
    const float** pp = (const float**)&p;
    for (int i = 0; i < 26; ++i) pp[i] = (const float*)d_in[i];
    p.out = (float*)d_out; p.ws = (char*)d_ws;
    static int grid = 0;
    if (!grid) {
        int dev = 0, cus = 0, per_cu = 0;
        (void)hipGetDevice(&dev);
        (void)hipDeviceGetAttribute(&cus, hipDeviceAttributeMultiprocessorCount, dev);
        (void)hipFuncSetAttribute((const void*)mega, hipFuncAttributeMaxDynamicSharedMemorySize, LDS_BYTES);
        (void)hipOccupancyMaxActiveBlocksPerMultiprocessor(&per_cu, mega, NT, LDS_BYTES);
        grid = per_cu >= 1 ? cus : 0;
    }
    (void)hipMemsetAsync((char*)d_ws + OFF_CTL, 0, CTL_BYTES, stream);
#if ONE_LAUNCH
    p.ph_lo = 0; p.ph_hi = N_PHASES;
    if (grid > 0) hipLaunchKernelGGL(mega, dim3(grid), dim3(NT), LDS_BYTES, stream, p);
#else
    for (int k = 0; k < N_PHASES; ++k) { p.ph_lo = k; p.ph_hi = k + 1; hipLaunchKernelGGL(mega, dim3(grid), dim3(NT), LDS_BYTES, stream, p); }
#endif
}
```
